# Optimizing an MI355X kernel written in HIP

```python
import jax, jax.numpy as jnp
from jax import lax
import numpy as np

D_MODEL = 1024
BATCH = 16
SEQ = 2048
DEPTH = 2
DEC_BATCH = 8
DEC_SEQ = 64
PAST_LEN = 2048

CHUNK = 64
N_A_LAYERS = DEPTH // 2
N_B_LAYERS = DEPTH - N_A_LAYERS
CONV_WIDTH = 31
CONV_STATE = CONV_WIDTH - 1
N_HEADS = 16
HEAD_DIM = D_MODEL // N_HEADS
N_KV_HEADS = 4
GROUP = N_HEADS // N_KV_HEADS
D_FF = -(-8 * D_MODEL // (3 * 256)) * 256
Q_BLOCK = 128
EPS = 1e-6

kernel_name = "yoco_conformer_conv_stick_breaking_stream_step"


def rmsnorm(x, g):
    xf = x.astype(jnp.float32)
    y = xf * lax.rsqrt(jnp.mean(xf * xf, axis=-1, keepdims=True) + EPS)
    return (y * g.astype(jnp.float32)).astype(x.dtype)


def layernorm(x, g, b):
    xf = x.astype(jnp.float32)
    mu = jnp.mean(xf, axis=-1, keepdims=True)
    xc = xf - mu
    y = xc * lax.rsqrt(jnp.mean(xc * xc, axis=-1, keepdims=True) + EPS)
    return (y * g.astype(jnp.float32) + b.astype(jnp.float32)).astype(x.dtype)


def swiglu(xn, w_gu, w_down):
    g, u = jnp.split(xn @ w_gu, 2, axis=-1)
    return (jax.nn.silu(g) * u) @ w_down


def conv_module(xn, prefix, w_in, b_in, w_dw, b_dw, ln_g, ln_b, w_out, b_out):
    a, gate = jnp.split(xn @ w_in + b_in, 2, axis=-1)
    u = a * jax.nn.sigmoid(gate)
    u_ext = jnp.concatenate([prefix.astype(u.dtype), u], axis=1)
    y = lax.conv_general_dilated(
        u_ext, w_dw[:, None, :], window_strides=(1,), padding='VALID',
        dimension_numbers=('NWC', 'WIO', 'NWC'),
        feature_group_count=D_MODEL) + b_dw
    y = jax.nn.silu(layernorm(y, ln_g, ln_b))
    return y @ w_out + b_out, u_ext[:, -CONV_STATE:]


def stick_breaking_block(q, k, v, q_pos, k_pos):
    z = jnp.einsum('bgrqd,bgsd->bgrqs', q, k,
                   preferred_element_type=jnp.float32) * (HEAD_DIM ** -0.5)
    mask = k_pos[None, :] < q_pos[:, None]
    log_beta = jax.nn.log_sigmoid(z)
    log_keep = jnp.where(mask, log_beta - z, 0.0)
    after = lax.cumsum(log_keep, axis=4, reverse=True) - log_keep
    att = jnp.where(mask, jnp.exp(log_beta + after), 0.0)
    return jnp.einsum('bgrqs,bgsd->bgrqd', att.astype(v.dtype), v)


def sb_attention(xn, k_all, v_all, q_pos, k_pos, w_q, w_o):
    bn, t, _ = xn.shape
    q = (xn @ w_q).reshape(bn, t, N_KV_HEADS, GROUP, HEAD_DIM).transpose(0, 2, 3, 1, 4)
    kt = k_all.transpose(0, 2, 1, 3)
    vt = v_all.transpose(0, 2, 1, 3)
    if t <= Q_BLOCK:
        o = stick_breaking_block(q, kt, vt, q_pos, k_pos)
    else:
        nb = t // Q_BLOCK
        qb = q.reshape(bn, N_KV_HEADS, GROUP, nb, Q_BLOCK, HEAD_DIM).transpose(3, 0, 1, 2, 4, 5)
        pb = q_pos.reshape(nb, Q_BLOCK)
        ob = lax.map(lambda a: stick_breaking_block(a[0], kt, vt, a[1], k_pos), (qb, pb))
        o = ob.transpose(1, 2, 3, 0, 4, 5).reshape(bn, N_KV_HEADS, GROUP, t, HEAD_DIM)
    o = o.transpose(0, 3, 1, 2, 4).reshape(bn, t, N_HEADS * HEAD_DIM)
    return o @ w_o


def trunk(x, conv_prefix, k_past, v_past,
          a_norm_g, conv_w_in, conv_b_in, conv_w_dw, conv_b_dw, conv_ln_g, conv_ln_b,
          conv_w_out, conv_b_out, kv_norm_g, w_kv, b_norm_g, w_q, w_o,
          ffn_norm_g, ffn_w_gu, ffn_w_down, final_norm_g):
    bn, t, _ = x.shape
    h = x
    conv_states = []
    k_new = v_new = k_all = v_all = q_pos = k_pos = None
    for l in range(DEPTH):
        if l < N_A_LAYERS:
            mix, st = conv_module(rmsnorm(h, a_norm_g[l]), conv_prefix[l],
                                  conv_w_in[l], conv_b_in[l], conv_w_dw[l], conv_b_dw[l],
                                  conv_ln_g[l], conv_ln_b[l], conv_w_out[l], conv_b_out[l])
            h = h + mix
            conv_states.append(st)
        else:
            if l == N_A_LAYERS:
                k_new, v_new = jnp.split(rmsnorm(h, kv_norm_g) @ w_kv, 2, axis=-1)
                k_new = k_new.reshape(bn, t, N_KV_HEADS, HEAD_DIM)
                v_new = v_new.reshape(bn, t, N_KV_HEADS, HEAD_DIM)
                if k_past is None:
                    past = 0
                    k_all, v_all = k_new, v_new
                else:
                    past = k_past.shape[1]
                    k_all = jnp.concatenate([k_past.astype(k_new.dtype), k_new], axis=1)
                    v_all = jnp.concatenate([v_past.astype(v_new.dtype), v_new], axis=1)
                q_pos = past + jnp.arange(t, dtype=jnp.int32)
                k_pos = jnp.arange(k_all.shape[1], dtype=jnp.int32)
            j = l - N_A_LAYERS
            h = h + sb_attention(rmsnorm(h, b_norm_g[j]), k_all, v_all, q_pos, k_pos, w_q[j], w_o[j])
        h = h + swiglu(rmsnorm(h, ffn_norm_g[l]), ffn_w_gu[l], ffn_w_down[l])
    return rmsnorm(h, final_norm_g), jnp.stack(conv_states), k_new, v_new


def setup_inputs(seed: int = 0) -> dict:
    key = jax.random.key(seed)
    ks = jax.random.split(key, 24)
    f32 = jnp.float32
    D, HD, KVD = D_MODEL, N_HEADS * HEAD_DIM, N_KV_HEADS * HEAD_DIM

    def nrm(k, shape, scale):
        return jax.random.normal(k, shape, f32) * scale

    def gain(k, shape):
        return 1.0 + 0.05 * jax.random.normal(k, shape, f32)

    return {
        "x_prompt": nrm(ks[0], (BATCH, SEQ, D), 1.0),
        "x_sample": nrm(ks[1], (DEC_BATCH, DEC_SEQ, D), 1.0),
        "state_conv": nrm(ks[2], (N_A_LAYERS, DEC_BATCH, CONV_STATE, D), 0.5),
        "cache_k": nrm(ks[3], (DEC_BATCH, PAST_LEN, N_KV_HEADS, HEAD_DIM), 1.0),
        "cache_v": nrm(ks[4], (DEC_BATCH, PAST_LEN, N_KV_HEADS, HEAD_DIM), 1.0),
        "a_norm_g": gain(ks[5], (N_A_LAYERS, D)),
        "conv_w_in": nrm(ks[6], (N_A_LAYERS, D, 2 * D), D ** -0.5),
        "conv_b_in": nrm(ks[7], (N_A_LAYERS, 2 * D), 0.02),
        "conv_w_dw": nrm(ks[8], (N_A_LAYERS, CONV_WIDTH, D), CONV_WIDTH ** -0.5),
        "conv_b_dw": nrm(ks[9], (N_A_LAYERS, D), 0.02),
        "conv_ln_g": gain(ks[10], (N_A_LAYERS, D)),
        "conv_ln_b": nrm(ks[11], (N_A_LAYERS, D), 0.02),
        "conv_w_out": nrm(ks[12], (N_A_LAYERS, D, D), D ** -0.5),
        "conv_b_out": nrm(ks[13], (N_A_LAYERS, D), 0.02),
        "kv_norm_g": gain(ks[14], (D,)),
        "w_kv": nrm(ks[15], (D, 2 * KVD), D ** -0.5),
        "b_norm_g": gain(ks[16], (N_B_LAYERS, D)),
        "w_q": nrm(ks[17], (N_B_LAYERS, D, HD), D ** -0.5),
        "w_o": nrm(ks[18], (N_B_LAYERS, HD, D), HD ** -0.5),
        "ffn_norm_g": gain(ks[19], (DEPTH, D)),
        "ffn_w_gu": nrm(ks[20], (DEPTH, D, 2 * D_FF), D ** -0.5),
        "ffn_w_down": nrm(ks[21], (DEPTH, D_FF, D), D_FF ** -0.5),
        "final_norm_g": gain(ks[22], (D,)),
    }


def reference(x_prompt, x_sample, state_conv, cache_k, cache_v,
              a_norm_g, conv_w_in, conv_b_in, conv_w_dw, conv_b_dw, conv_ln_g, conv_ln_b,
              conv_w_out, conv_b_out, kv_norm_g, w_kv, b_norm_g, w_q, w_o,
              ffn_norm_g, ffn_w_gu, ffn_w_down, final_norm_g):
    weights = (a_norm_g, conv_w_in, conv_b_in, conv_w_dw, conv_b_dw, conv_ln_g, conv_ln_b,
               conv_w_out, conv_b_out, kv_norm_g, w_kv, b_norm_g, w_q, w_o,
               ffn_norm_g, ffn_w_gu, ffn_w_down, final_norm_g)
    zero_prefix = jnp.zeros((N_A_LAYERS, x_prompt.shape[0], CONV_STATE, D_MODEL), x_prompt.dtype)
    y_prompt, conv_state_prompt, k_prompt, v_prompt = trunk(
        x_prompt, zero_prefix, None, None, *weights)
    y_sample, conv_state_sample, k_sample, v_sample = trunk(
        x_sample, state_conv, cache_k, cache_v, *weights)
    return (y_prompt, y_sample, conv_state_prompt, k_prompt, v_prompt,
            conv_state_sample, k_sample, v_sample)
```

```cpp
#include <hip/hip_runtime.h>
#include <hip/hip_cooperative_groups.h>
#include <cstdio>
#include <cstdint>
namespace cg = cooperative_groups;

#ifndef USE_XCD_BAR
#define USE_XCD_BAR 1
#endif
#ifndef REP_P0
#define REP_P0 1
#endif
#ifndef REP_P2
#define REP_P2 1
#endif
#ifndef REP_P4
#define REP_P4 1
#endif
#ifndef REP_P7
#define REP_P7 1
#endif
#ifndef REP_EPI_GLU
#define REP_EPI_GLU 1
#endif
#ifndef REP_SG
#define REP_SG 1
#endif
#ifndef ATTN_EARLY_EXIT
#define ATTN_EARLY_EXIT 1
#endif

#define LAS __attribute__((address_space(3)))
#define GAS __attribute__((address_space(1)))
typedef unsigned short bf16_t;
typedef short bf16x8 __attribute__((ext_vector_type(8)));
typedef float f32x4 __attribute__((ext_vector_type(4)));
typedef float f32x2 __attribute__((ext_vector_type(2)));
typedef float f32x16 __attribute__((ext_vector_type(16)));
typedef unsigned u32x4 __attribute__((ext_vector_type(4)));
typedef unsigned u32x2 __attribute__((ext_vector_type(2)));

constexpr int D = 1024, SEQ = 2048, NB_P = 16, NB_S = 8, DSEQ = 64, PAST = 2048, SKV_S = PAST + DSEQ;
constexpr int T_P = NB_P * SEQ, T_S = NB_S * DSEQ, T = T_P + T_S;
constexpr int DFF = 2816, CW = 31, CST = 30, KVD = 256;
constexpr float EPS = 1e-6f;
constexpr float QSCALE = 0.125f * 1.4426950408889634f;
constexpr size_t O_Y = 0, O_CSP = (size_t)T * D, O_KP = O_CSP + (size_t)NB_P * CST * D, O_VP = O_KP + (size_t)T_P * KVD,
                 O_CSS = O_VP + (size_t)T_P * KVD, O_KS = O_CSS + (size_t)NB_S * CST * D, O_VS = O_KS + (size_t)T_S * KVD;
constexpr size_t MiB = 1u << 20;
constexpr size_t WS_CTL = 0, WS_SS = 1 * MiB, WS_WIN = 2 * MiB, WS_WOUT = 6 * MiB, WS_WGU0 = 8 * MiB, WS_WGU1 = 19 * MiB, WS_WD0 = 30 * MiB, WS_WD1 = 36 * MiB,
                 WS_WKVQ = 42 * MiB, WS_WO = 45 * MiB, WS_KP = 47 * MiB, WS_KS = 63 * MiB, WS_VTP = 72 * MiB, WS_VTS = 88 * MiB,
                 WS_S1 = 97 * MiB, WS_S2 = 162 * MiB, WS_HID = 227 * MiB, WS_S3 = 406 * MiB, WS_END = 471 * MiB;
constexpr size_t CTL_BYTES = 64 * 1024;

typedef __bf16 bf16x2_t __attribute__((ext_vector_type(2)));
__device__ __forceinline__ unsigned cvt_pk_bf16(float lo, float hi) { const f32x2 v = {lo, hi}; const bf16x2_t b = __builtin_convertvector(v, bf16x2_t); return __builtin_bit_cast(unsigned, b); }
__device__ __forceinline__ float fast_sigmoid(float x) { return __builtin_amdgcn_rcpf(1.0f + __builtin_amdgcn_exp2f(-1.4426950408889634f * x)); }
__device__ __forceinline__ float wave_sum(float v) {
#pragma unroll
    for (int o = 1; o < 64; o <<= 1) v += __shfl_xor(v, o);
    return v;
}
#define LDS_WAIT() asm volatile("s_waitcnt lgkmcnt(0)" ::: "memory")

namespace pg8 {
#define PG8_LAS __attribute__((address_space(3)))
constexpr int BM = 256, BK = 64, HALF = 128, HTB = HALF * BK * 2, STAGE_BYTES = 8 * HTB, NXCD = 8, WGM = 8;
__host__ __device__ __forceinline__ int lds_byte(int r, int c) { const int st = (r >> 4) * 2 + (c >> 5), rr = r & 15, cc = c & 31, ob = rr * 64 + cc * 2; return st * 1024 + (ob ^ (((ob >> 9) & 1) << 5)); }
__host__ __device__ __forceinline__ void stage_rc(int b, int& R, int& C) { const int st = b / 1024, sb = b % 1024, swz = sb ^ (((sb >> 9) & 1) << 5); R = (st >> 1) * 16 + swz / 64; C = (st & 1) * 32 + (swz % 64) / 2; }
__host__ __device__ __forceinline__ int perm32(int rho) { const int n = rho >> 4, i = rho & 15; return 8 * (i >> 2) + 4 * n + (i & 3); }
struct Unit { int pm, pn; };
struct Gemm { const bf16_t* A; const bf16_t* Bt; int M, N, K; };
struct StaticOrder {
    int nM, nN, nwg, G, c;
    __host__ __device__ void init(int M, int N, int G_, int c_) { nM = M / BM; nN = N / BM; nwg = nM * nN; G = G_; c = c_; }
    __host__ __device__ bool next(int i, Unit& u) const {
        const long L = (long)i * G + c; if (L >= nwg) return false;
        int wgid = (int)L; { const int q = nwg / NXCD, r = nwg % NXCD, xcd = wgid % NXCD, off = wgid / NXCD; wgid = (xcd < r ? xcd * (q + 1) : r * (q + 1) + (xcd - r) * q) + off; }
        const int nig = WGM * nN, gid = wgid / nig, fm = gid * WGM, gsz = (nM - fm) < WGM ? (nM - fm) : WGM;
        u.pm = fm + ((wgid % nig) % gsz); u.pn = (wgid % nig) / gsz; return true;
    }
    __device__ __forceinline__ void a_ready(const Unit&) const {}
    __device__ __forceinline__ void done(const Unit&) const {}
};

template <class Epi, class Sched, bool ALIGN_EPI = false>
__device__ __forceinline__ void gemm_phase(PG8_LAS unsigned char* lds, const Gemm g, const Sched& S, const Epi& E) {
    int tid_ = threadIdx.x; asm volatile("" : "+v"(tid_));
    const int tid = tid_, wid = __builtin_amdgcn_readfirstlane(tid >> 6), lane = tid & 63, wr = wid >> 2, wc = wid & 3, fr = lane & 15, fq = lane >> 4;
    const int K = g.K, nt = K / BK;
    unsigned voffA[2], voffB[2];
#pragma unroll
    for (int i = 0; i < 2; ++i) { int R, C; stage_rc(tid * 16 + i * 8192, R, C); const int Rb = Epi::PERM ? ((R & ~31) + perm32(R & 31)) : R;
        voffA[i] = (unsigned)(R * K + C) * 2u; voffB[i] = (unsigned)(Rb * K + C) * 2u; }
    const size_t kstep = (size_t)(BK * 2);
    const size_t hstep = (size_t)HALF * K * 2;
    const size_t tstep = 2 * hstep;
    const unsigned ldsw = (unsigned)wid * 1024u;
    const int aoff = lds_byte(wr * 64 + fr, fq * 8), boff = lds_byte(wc * 32 + fr, fq * 8);
#define PG8_SA(b, h) (((b) * 2 + (h)) * HTB)
#define PG8_SB(b, h) ((4 + (b) * 2 + (h)) * HTB)
#define PG8_STAGE(bufoff, gbase, voff) do { _Pragma("unroll") for (int _i = 0; _i < 2; ++_i) \
        __builtin_amdgcn_global_load_lds((const unsigned*)((const char*)(gbase) + (voff)[_i]), (PG8_LAS unsigned*)(lds + (bufoff) + ldsw + _i * 8192), 16, 0, 0); } while (0)
#define PG8_LDA(dst, b, h) do { _Pragma("unroll") for (int m = 0; m < 4; ++m) _Pragma("unroll") for (int k = 0; k < 2; ++k) dst[m][k] = *(const PG8_LAS bf16x8*)(lds + PG8_SA(b, h) + aoff + m * 2048 + k * 1024); } while (0)
#define PG8_LDB(dst, b, h) do { _Pragma("unroll") for (int n = 0; n < 2; ++n) _Pragma("unroll") for (int k = 0; k < 2; ++k) dst[n][k] = *(const PG8_LAS bf16x8*)(lds + PG8_SB(b, h) + boff + n * 2048 + k * 1024); } while (0)
#define PG8_MMA(ai, bj, At, Bt) do { __builtin_amdgcn_s_setprio(1); _Pragma("unroll") for (int m = 0; m < 4; ++m) _Pragma("unroll") for (int n = 0; n < 2; ++n) _Pragma("unroll") for (int k = 0; k < 2; ++k) \
        acc[ai][bj][m][n] = __builtin_amdgcn_mfma_f32_16x16x32_bf16(Bt[n][k], At[m][k], acc[ai][bj][m][n], 0, 0, 0); __builtin_amdgcn_s_setprio(0); } while (0)
#define PG8_WAIT_V(n) asm volatile("s_waitcnt vmcnt(" #n ")" ::: "memory")
#define PG8_WAIT_L(n) asm volatile("s_waitcnt lgkmcnt(" #n ")" ::: "memory")
#define PG8_BAR __builtin_amdgcn_s_barrier()
#define PG8_SCHED __builtin_amdgcn_sched_barrier(0)
    Unit cur, nxt; int ui = 0;
    if (!S.next(0, cur)) return;
    f32x4 acc[2][2][4][2];
#pragma unroll
    for (int a = 0; a < 2; ++a)
#pragma unroll
        for (int b = 0; b < 2; ++b)
#pragma unroll
            for (int m = 0; m < 4; ++m)
#pragma unroll
                for (int n = 0; n < 2; ++n) acc[a][b][m][n] = (f32x4){0.f, 0.f, 0.f, 0.f};
    bf16x8 At[4][2], B0[2][2], B1[2][2];
    const char* cA = (const char*)g.A + (size_t)cur.pm * tstep; const char* cB = (const char*)g.Bt + (size_t)cur.pn * tstep;
    S.a_ready(cur);
    PG8_STAGE(PG8_SB(0, 0), cB, voffB); PG8_STAGE(PG8_SB(0, 1), cB + hstep, voffB); PG8_STAGE(PG8_SA(0, 0), cA, voffA); PG8_STAGE(PG8_SA(0, 1), cA + hstep, voffA);
    if (wr == 1) PG8_BAR;
    PG8_WAIT_V(2); PG8_BAR;
    PG8_STAGE(PG8_SB(1, 0), cB + kstep, voffB); PG8_STAGE(PG8_SA(1, 0), cA + kstep, voffA); PG8_STAGE(PG8_SB(1, 1), cB + hstep + kstep, voffB);
    PG8_WAIT_V(6); PG8_BAR;
    for (;;) {
        const bool has_next = S.next(ui + 1, nxt);
        const char* nA = has_next ? (const char*)g.A + (size_t)nxt.pm * tstep : cA; const char* nB = has_next ? (const char*)g.Bt + (size_t)nxt.pn * tstep : cB;
        for (int t = 0; t < nt; t += 2) {
            const bool last = (t == nt - 2);
            const char* a1 = cA + (size_t)(t + 1) * kstep;
            const char* a2 = last ? nA : cA + (size_t)(t + 2) * kstep; const char* b2 = last ? nB : cB + (size_t)(t + 2) * kstep;
            const char* a3 = a2 + kstep; const char* b3 = b2 + kstep;
            if (last && has_next) S.a_ready(nxt);
            PG8_LDB(B0, 0, 0); PG8_LDB(B1, 0, 1); PG8_SCHED; PG8_LDA(At, 0, 0); PG8_STAGE(PG8_SA(1, 1), a1 + hstep, voffA);
            PG8_WAIT_V(8); PG8_WAIT_L(0); PG8_BAR; PG8_MMA(0, 0, At, B0); PG8_MMA(0, 1, At, B1); PG8_BAR; PG8_SCHED;
            PG8_LDA(At, 0, 1); PG8_STAGE(PG8_SB(0, 0), b2, voffB); PG8_STAGE(PG8_SB(0, 1), b2 + hstep, voffB); PG8_STAGE(PG8_SA(0, 0), a2, voffA);
            PG8_WAIT_V(8); PG8_WAIT_L(0); PG8_BAR; PG8_MMA(1, 0, At, B0); PG8_MMA(1, 1, At, B1); PG8_BAR; PG8_SCHED;
            PG8_LDB(B0, 1, 0); PG8_LDB(B1, 1, 1); PG8_SCHED; PG8_LDA(At, 1, 0); PG8_STAGE(PG8_SA(0, 1), a2 + hstep, voffA);
            PG8_WAIT_V(8); PG8_WAIT_L(0); PG8_BAR; PG8_MMA(0, 0, At, B0); PG8_MMA(0, 1, At, B1); PG8_BAR; PG8_SCHED;
            PG8_LDA(At, 1, 1); PG8_STAGE(PG8_SB(1, 0), b3, voffB); PG8_STAGE(PG8_SB(1, 1), b3 + hstep, voffB); PG8_STAGE(PG8_SA(1, 0), a3, voffA);
            PG8_WAIT_V(8); PG8_WAIT_L(0); PG8_BAR; PG8_MMA(1, 0, At, B0); PG8_MMA(1, 1, At, B1); PG8_BAR; PG8_SCHED;
        }
        if constexpr (ALIGN_EPI) { if (wr == 0) PG8_BAR; }
        for (int r_ = 0; r_ < Epi::REP; ++r_) E(acc, cur, wr, wc, fr, fq);
        S.done(cur);
        if (!has_next) break;
#pragma unroll
        for (int a = 0; a < 2; ++a)
#pragma unroll
            for (int b = 0; b < 2; ++b)
#pragma unroll
                for (int m = 0; m < 4; ++m)
#pragma unroll
                    for (int n = 0; n < 2; ++n) acc[a][b][m][n] = (f32x4){0.f, 0.f, 0.f, 0.f};
        cur = nxt; cA = nA; cB = nB; ++ui;
        if constexpr (ALIGN_EPI) { if (wr == 1) PG8_BAR; }
    }
    PG8_WAIT_V(0);
    if constexpr (!ALIGN_EPI) { if (wr == 0) PG8_BAR; }
    PG8_BAR;
#undef PG8_SA
#undef PG8_SB
#undef PG8_STAGE
#undef PG8_LDA
#undef PG8_LDB
#undef PG8_MMA
#undef PG8_WAIT_V
#undef PG8_WAIT_L
#undef PG8_BAR
#undef PG8_SCHED
}
}

template <int MODE> struct EpiGlu {
    static constexpr bool PERM = true; static constexpr int REP = (MODE == 1) ? REP_EPI_GLU : 1;
    bf16_t* O; int ldo; const float* ss; const float* bias; float* csp; float* css;
    __device__ __forceinline__ void operator()(const f32x4 (&acc)[2][2][4][2], const pg8::Unit& u, int wr, int wc, int fr, int fq) const {
        const int col = u.pn * 128 + wc * 32 + 8 * fq;
        f32x4 ba[2], bg[2];
        if (MODE == 0) {
#pragma unroll
            for (int n = 0; n < 2; ++n) { ba[n] = *(const f32x4*)(bias + col + 4 * n); bg[n] = *(const f32x4*)(bias + D + col + 4 * n); }
        }
#pragma unroll
        for (int ai = 0; ai < 2; ++ai)
#pragma unroll
            for (int m = 0; m < 4; ++m) {
                const int row = u.pm * 256 + ai * 128 + wr * 64 + m * 16 + fr;
                const float vv = ss[row] * (1.0f / D) + EPS, rs = __builtin_amdgcn_rsqf(vv);
                f32x4 o[2];
                constexpr float NL2E = -1.4426950408889634f;
                const float c1 = rs * NL2E;
#pragma unroll
                for (int n = 0; n < 2; ++n)
#pragma unroll
                    for (int h = 0; h < 2; ++h) {
                        const f32x2 a2 = (f32x2){acc[ai][0][m][n][2 * h], acc[ai][0][m][n][2 * h + 1]}, g2 = (f32x2){acc[ai][1][m][n][2 * h], acc[ai][1][m][n][2 * h + 1]};
                        f32x2 t2, val2;
                        if (MODE == 0) { const f32x2 bg2 = (f32x2){bg[n][2 * h], bg[n][2 * h + 1]}, ba2 = (f32x2){ba[n][2 * h], ba[n][2 * h + 1]};
                            t2 = g2 * c1 + bg2 * NL2E; val2 = a2 * rs + ba2; }
                        else { t2 = a2 * c1; val2 = a2 * g2; }
                        f32x2 e2; e2.x = __builtin_amdgcn_exp2f(t2.x); e2.y = __builtin_amdgcn_exp2f(t2.y);
                        const f32x2 d2 = (MODE == 0) ? e2 + 1.0f : e2 * vv + vv;
                        f32x2 r2; r2.x = __builtin_amdgcn_rcpf(d2.x); r2.y = __builtin_amdgcn_rcpf(d2.y);
                        const f32x2 q2 = val2 * r2;
                        o[n][2 * h] = q2.x; o[n][2 * h + 1] = q2.y;
                    }
                u32x4 w; w.x = cvt_pk_bf16(o[0][0], o[0][1]); w.y = cvt_pk_bf16(o[0][2], o[0][3]); w.z = cvt_pk_bf16(o[1][0], o[1][1]); w.w = cvt_pk_bf16(o[1][2], o[1][3]);
                *(u32x4*)(O + (size_t)row * ldo + col) = w;
                if (MODE == 0) {
                    float* cs = nullptr;
                    if (row < T_P) { const int t = row & (SEQ - 1); if (t >= SEQ - CST) cs = csp + ((size_t)(row >> 11) * CST + (t - (SEQ - CST))) * D; }
                    else { const int r2 = row - T_P, t = r2 & (DSEQ - 1); if (t >= DSEQ - CST) cs = css + ((size_t)(r2 >> 6) * CST + (t - (DSEQ - CST))) * D; }
                    if (cs) { *(f32x4*)(cs + col) = o[0]; *(f32x4*)(cs + col + 4) = o[1]; }
                }
            }
    }
};
__device__ __forceinline__ f32x4 bf_lo4(u32x4 p) { return (f32x4){__uint_as_float(p.x << 16), __uint_as_float(p.x & 0xffff0000u), __uint_as_float(p.y << 16), __uint_as_float(p.y & 0xffff0000u)}; }
__device__ __forceinline__ f32x4 bf_hi4(u32x4 p) { return (f32x4){__uint_as_float(p.z << 16), __uint_as_float(p.z & 0xffff0000u), __uint_as_float(p.w << 16), __uint_as_float(p.w & 0xffff0000u)}; }
template <int MODE> struct EpiRes {
    static constexpr bool PERM = true; static constexpr int REP = 1;
    const float* xp; const float* xs; const bf16_t* Bin; bf16_t* B; float* ss; const float* bias;
    __device__ __forceinline__ void operator()(const f32x4 (&acc)[2][2][4][2], const pg8::Unit& u, int wr, int wc, int fr, int fq) const {
        const int col = u.pn * 256 + wc * 32 + 8 * fq;
        f32x4 bv[2][2];
        if (MODE == 0) {
#pragma unroll
            for (int bj = 0; bj < 2; ++bj)
#pragma unroll
                for (int n = 0; n < 2; ++n) bv[bj][n] = *(const f32x4*)(bias + col + bj * 128 + 4 * n);
        }
#pragma unroll
        for (int ai = 0; ai < 2; ++ai) {
            u32x4 bp[4][2];
#pragma unroll
            for (int m = 0; m < 4; ++m) {
                const int row = u.pm * 256 + ai * 128 + wr * 64 + m * 16 + fr;
#pragma unroll
                for (int bj = 0; bj < 2; ++bj) bp[m][bj] = *(const u32x4*)(Bin + (size_t)row * D + col + bj * 128);
            }
            __builtin_amdgcn_sched_barrier(0);
#pragma unroll
            for (int m = 0; m < 4; ++m) {
                const int row = u.pm * 256 + ai * 128 + wr * 64 + m * 16 + fr;
                f32x2 sq2 = (f32x2){0.f, 0.f};
#pragma unroll
                for (int bj = 0; bj < 2; ++bj) {
                    const int c = col + bj * 128;
                    const u32x4 bq = bp[m][bj];
                    u32x4 w;
#pragma unroll
                    for (int h = 0; h < 4; ++h) {
                        const f32x2 base2 = (f32x2){__uint_as_float(bq[h] << 16), __uint_as_float(bq[h] & 0xffff0000u)};
                        const f32x4 a4 = acc[ai][bj][m][h >> 1];
                        f32x2 v2 = base2 + (f32x2){a4[2 * (h & 1)], a4[2 * (h & 1) + 1]};
                        if (MODE == 0) v2 += (f32x2){bv[bj][h >> 1][2 * (h & 1)], bv[bj][h >> 1][2 * (h & 1) + 1]};
                        w[h] = cvt_pk_bf16(v2.x, v2.y);
                        sq2 = v2 * v2 + sq2;
                    }
                    *(u32x4*)(B + (size_t)row * D + c) = w;
                }
                float sq = sq2.x + sq2.y;
                sq += __shfl_xor(sq, 16); sq += __shfl_xor(sq, 32);
                if (fq == 0) atomicAdd(ss + row, sq);
            }
            asm volatile("" ::: "memory");
        }
    }
};
__device__ __forceinline__ int kperm(int t) { return (t & ~12) | ((t & 4) << 1) | ((t & 8) >> 1); }
struct EpiKvq {
    static constexpr bool PERM = true; static constexpr int REP = 1;
    const float* ss; float* out; bf16_t* Kp; bf16_t* Ks; bf16_t* Vtp; bf16_t* Vts; bf16_t* Q;
    __device__ __forceinline__ void operator()(const f32x4 (&acc)[2][2][4][2], const pg8::Unit& u, int wr, int wc, int fr, int fq) const {
#pragma unroll
        for (int ai = 0; ai < 2; ++ai)
#pragma unroll
            for (int m = 0; m < 4; ++m) {
                const int row = u.pm * 256 + ai * 128 + wr * 64 + m * 16 + fr;
                const float rs = __builtin_amdgcn_rsqf(ss[row] * (1.0f / D) + EPS);
                constexpr bool prompt = true; const int r2 = 0;
                const int b = prompt ? (row >> 11) : (r2 >> 6), t = prompt ? (row & (SEQ - 1)) : (r2 & (DSEQ - 1));
#pragma unroll
                for (int bj = 0; bj < 2; ++bj) {
                    const int c = bj * 128 + wc * 32 + 8 * fq;
                    f32x4 v0 = acc[ai][bj][m][0] * rs, v1 = acc[ai][bj][m][1] * rs;
                    if (u.pn == 0) {
                        float* ko = prompt ? out + O_KP + (size_t)row * KVD : out + O_KS + (size_t)r2 * KVD;
                        *(f32x4*)(ko + c) = v0; *(f32x4*)(ko + c + 4) = v1;
                        bf16_t* kb = prompt ? Kp + (size_t)row * KVD : Ks + ((size_t)b * SKV_S + PAST + t) * KVD;
                        u32x4 w; w.x = cvt_pk_bf16(v0[0], v0[1]); w.y = cvt_pk_bf16(v0[2], v0[3]); w.z = cvt_pk_bf16(v1[0], v1[1]); w.w = cvt_pk_bf16(v1[2], v1[3]);
                        *(u32x4*)(kb + c) = w;
                    } else if (u.pn == 1) {
                        float* vo = prompt ? out + O_VP + (size_t)row * KVD : out + O_VS + (size_t)r2 * KVD;
                        *(f32x4*)(vo + c) = v0; *(f32x4*)(vo + c + 4) = v1;
                        bf16_t* vb = prompt ? Vtp + (size_t)row * KVD : Vts + ((size_t)b * SKV_S + PAST + t) * KVD;
                        u32x4 w; w.x = cvt_pk_bf16(v0[0], v0[1]); w.y = cvt_pk_bf16(v0[2], v0[3]); w.z = cvt_pk_bf16(v1[0], v1[1]); w.w = cvt_pk_bf16(v1[2], v1[3]);
                        *(u32x4*)(vb + c) = w;
                    } else {
                        v0 *= QSCALE; v1 *= QSCALE;
                        u32x4 w; w.x = cvt_pk_bf16(v0[0], v0[1]); w.y = cvt_pk_bf16(v0[2], v0[3]); w.z = cvt_pk_bf16(v1[0], v1[1]); w.w = cvt_pk_bf16(v1[2], v1[3]);
                        *(u32x4*)(Q + (size_t)row * D + (u.pn - 2) * 256 + c) = w;
                    }
                }
            }
    }
};

template <int NB> __device__ __forceinline__ void sg32_tile(const bf16_t* __restrict__ ga, const bf16_t* __restrict__ gb0, const bf16_t* __restrict__ gb1, int ld, int nch, LAS unsigned char* stg, int lane, f32x16& c0, f32x16& c1) {
    c0 = f32x16{}; c1 = f32x16{};
    const int lr = lane >> 3, lc = lane & 7, r32 = lane & 31, hi = lane >> 5;
    const size_t goff = (size_t)lr * ld + lc * 8;
    ga += goff; gb0 += goff; if (NB == 2) gb1 += goff;
    LAS unsigned char* wr = stg + lr * 144 + lc * 16;
    const LAS unsigned char* rd = stg + r32 * 144 + hi * 16;
    u32x4 va[4], vb0[4], vb1[4];
#define SG_LOADG() do { _Pragma("unroll") for (int j = 0; j < 4; ++j) { va[j] = *(const u32x4*)(ga + (size_t)8 * j * ld); vb0[j] = *(const u32x4*)(gb0 + (size_t)8 * j * ld); if (NB == 2) vb1[j] = *(const u32x4*)(gb1 + (size_t)8 * j * ld); } \
        ga += 64; gb0 += 64; if (NB == 2) gb1 += 64; } while (0)
    SG_LOADG();
#pragma unroll 1
    for (int ch = 0; ch < nch; ++ch) {
#pragma unroll
        for (int j = 0; j < 4; ++j) { *(LAS u32x4*)(wr + j * 8 * 144) = va[j]; *(LAS u32x4*)(wr + 4608 + j * 8 * 144) = vb0[j]; if (NB == 2) *(LAS u32x4*)(wr + 9216 + j * 8 * 144) = vb1[j]; }
        __builtin_amdgcn_sched_barrier(0);
        if (ch + 1 < nch) SG_LOADG();
        __builtin_amdgcn_sched_barrier(0);
#pragma unroll
        for (int i = 0; i < 4; ++i) {
            const bf16x8 a = *(const LAS bf16x8*)(rd + i * 32), b0 = *(const LAS bf16x8*)(rd + 4608 + i * 32);
            c0 = __builtin_amdgcn_mfma_f32_32x32x16_bf16(b0, a, c0, 0, 0, 0);
            if (NB == 2) { const bf16x8 b1 = *(const LAS bf16x8*)(rd + 9216 + i * 32); c1 = __builtin_amdgcn_mfma_f32_32x32x16_bf16(b1, a, c1, 0, 0, 0); }
        }
        __builtin_amdgcn_sched_barrier(0);
    }
#undef SG_LOADG
}
__device__ __forceinline__ u32x2 pack4(f32x4 v) { u32x2 w; w.x = cvt_pk_bf16(v[0], v[1]); w.y = cvt_pk_bf16(v[2], v[3]); return w; }
#define F4(c, a) ((f32x4){(c)[4 * (a)], (c)[4 * (a) + 1], (c)[4 * (a) + 2], (c)[4 * (a) + 3]})
template <int MODE> struct SEpiGlu {
    bf16_t* O; int ldo; const float* ss; const float* bias; float* css;
    __device__ __forceinline__ void operator()(int rb, int cb, const f32x16& c0, const f32x16& c1, int r32, int hi) const {
        const int row = T_P + rb * 32 + r32;
        const float rs = __builtin_amdgcn_rsqf(ss[row] * (1.0f / D) + EPS);
#pragma unroll
        for (int a4 = 0; a4 < 4; ++a4) {
            const int col = cb * 32 + 8 * a4 + 4 * hi;
            f32x4 a = F4(c0, a4) * rs, g = F4(c1, a4) * rs, o;
            if (MODE == 0) { a += *(const f32x4*)(bias + col); g += *(const f32x4*)(bias + D + col);
#pragma unroll
                for (int e = 0; e < 4; ++e) o[e] = a[e] * fast_sigmoid(g[e]);
            } else {
#pragma unroll
                for (int e = 0; e < 4; ++e) o[e] = a[e] * fast_sigmoid(a[e]) * g[e];
            }
            *(u32x2*)(O + (size_t)row * ldo + col) = pack4(o);
            if (MODE == 0) { const int r2 = row - T_P, t = r2 & (DSEQ - 1); if (t >= DSEQ - CST) *(f32x4*)(css + ((size_t)(r2 >> 6) * CST + (t - (DSEQ - CST))) * D + col) = o; }
        }
    }
};
template <int MODE> struct SEpiRes {
    const float* xs; const bf16_t* Bin; bf16_t* B; float* ssout; const float* bias;
    __device__ __forceinline__ void operator()(int rb, int cb, const f32x16& c0, const f32x16&, int r32, int hi) const {
        const int row = T_P + rb * 32 + r32;
        float sq = 0.f;
#pragma unroll
        for (int a4 = 0; a4 < 4; ++a4) {
            const int col = cb * 32 + 8 * a4 + 4 * hi;
            f32x4 v;
            { const u32x2 pk = *(const u32x2*)(Bin + (size_t)row * D + col);
                v = (f32x4){__uint_as_float(pk.x << 16), __uint_as_float(pk.x & 0xffff0000u), __uint_as_float(pk.y << 16), __uint_as_float(pk.y & 0xffff0000u)} + F4(c0, a4); }
            if (MODE == 0) v += *(const f32x4*)(bias + col);
            *(u32x2*)(B + (size_t)row * D + col) = pack4(v);
            sq += (v[0] * v[0] + v[1] * v[1]) + (v[2] * v[2] + v[3] * v[3]);
        }
        sq += __shfl_xor(sq, 32);
        if (hi == 0) atomicAdd(ssout + row, sq);
    }
};
struct SEpiKvq {
    const float* ss; float* out; bf16_t* Ks; bf16_t* Vts; bf16_t* Q;
    __device__ __forceinline__ void operator()(int rb, int cb, const f32x16& c0, const f32x16&, int r32, int hi) const {
        const int row = T_P + rb * 32 + r32, r2 = row - T_P, b = r2 >> 6, t = r2 & (DSEQ - 1);
        const float rs = __builtin_amdgcn_rsqf(ss[row] * (1.0f / D) + EPS);
#pragma unroll
        for (int a4 = 0; a4 < 4; ++a4) {
            const int col = cb * 32 + 8 * a4 + 4 * hi;
            f32x4 v = F4(c0, a4) * rs;
            if (col < 256) {
                *(f32x4*)(out + O_KS + (size_t)r2 * KVD + col) = v;
                *(u32x2*)(Ks + ((size_t)b * SKV_S + PAST + t) * KVD + col) = pack4(v);
            } else if (col < 512) {
                const int cc = col - 256;
                *(f32x4*)(out + O_VS + (size_t)r2 * KVD + cc) = v;
                *(u32x2*)(Vts + ((size_t)b * SKV_S + PAST + t) * KVD + cc) = pack4(v);
            } else {
                v *= QSCALE;
                *(u32x2*)(Q + (size_t)row * D + (col - 512)) = pack4(v);
            }
        }
    }
};
template <int NB, int KS, class Epi>
__device__ __forceinline__ void sg32_phase(const bf16_t* A, const bf16_t* Bt, int K, int ncb, const Epi& epi, LAS unsigned char* lds, int bx, int G, int wave, int lane) {
    const int r32 = lane & 31, hi = lane >> 5;
    constexpr int TPW = 8 / KS;
    const int nitem = 16 * ncb, nrounds = (nitem + G * TPW - 1) / (G * TPW), nchunk = K / 64;
    const int ks = wave % KS, slot = wave / KS;
    const int per = nchunk / KS, rem = nchunk % KS, mych = per + (ks < rem ? 1 : 0), ch0 = ks * per + (ks < rem ? ks : rem);
    for (int rnd = 0; rnd < nrounds; ++rnd) {
        const int it = (rnd * G + bx) * TPW + slot; const bool valid = it < nitem;
        const int rb = it & 15, cb = it >> 4;
        f32x16 c0 = {}, c1 = {};
        if (valid) {
            const int brow = (NB == 2) ? ((cb >> 2) * 256 + (cb & 3) * 32) : cb * 32;
            const bf16_t* ap = A + (size_t)(T_P + rb * 32) * K + ch0 * 64;
            const bf16_t* bp0 = Bt + (size_t)brow * K + ch0 * 64;
            sg32_tile<NB>(ap, bp0, bp0 + (size_t)128 * K, K, mych, lds + wave * 13824, lane, c0, c1);
        }
        if (KS > 1) {
            __syncthreads();
            if (valid && ks != 0) {
#pragma unroll
                for (int q = 0; q < 4; ++q) { *(LAS f32x4*)(lds + wave * 8192 + q * 1024 + lane * 16) = F4(c0, q); if (NB == 2) *(LAS f32x4*)(lds + wave * 8192 + 4096 + q * 1024 + lane * 16) = F4(c1, q); }
            }
            __syncthreads();
            if (valid && ks == 0) {
#pragma unroll
                for (int pw = 1; pw < KS; ++pw)
#pragma unroll
                    for (int q = 0; q < 4; ++q) {
                        const f32x4 t0 = *(const LAS f32x4*)(lds + (wave + pw) * 8192 + q * 1024 + lane * 16);
                        c0[4 * q] += t0[0]; c0[4 * q + 1] += t0[1]; c0[4 * q + 2] += t0[2]; c0[4 * q + 3] += t0[3];
                        if (NB == 2) { const f32x4 t1 = *(const LAS f32x4*)(lds + (wave + pw) * 8192 + 4096 + q * 1024 + lane * 16);
                            c1[4 * q] += t1[0]; c1[4 * q + 1] += t1[1]; c1[4 * q + 2] += t1[2]; c1[4 * q + 3] += t1[3]; }
                    }
            }
        }
        if (valid && ks == 0) epi(rb, cb, c0, c1, r32, hi);
        if (KS > 1) __syncthreads();
    }
}

__device__ __forceinline__ int crow(int r, int hi) { return (r & 3) + 8 * (r >> 2) + 4 * hi; }
__device__ __forceinline__ void attn_unit(const bf16_t* __restrict__ Qp, const bf16_t* __restrict__ Kb, const bf16_t* __restrict__ Vb, int S, int qpos0, int kt_top, bf16_t* Op, LAS unsigned char* lds, int tid, int lane, int wave, const float* __restrict__ Kf, const float* __restrict__ Vf, int ktf) {
    const int r32 = lane & 31, hi = lane >> 5;
    bf16x8 qr[4];
#pragma unroll
    for (int d0 = 0; d0 < 4; ++d0) qr[d0] = *(const bf16x8*)(Qp + (size_t)r32 * D + d0 * 16 + hi * 8);
    f32x16 o0 = {}, o1 = {};
    float carry = 1.f;
    const int qpos = qpos0 + r32;
    const int lrow = tid >> 3, lch = tid & 7;
    const bf16_t* kg = Kb + (size_t)lrow * KVD + lch * 8;
    const bf16_t* vg = Vb + (size_t)lrow * KVD + lch * 8;
    LAS unsigned char* wK = lds + lrow * 144 + lch * 16;
    const LAS unsigned char* rK = lds + r32 * 144 + hi * 16;
    volatile LAS unsigned* flags = (volatile LAS unsigned*)(lds + 36864);
    LAS unsigned char* wV = lds + 9216 + lch * 8 * 144 + kperm(lrow) * 2;
    u32x4 kreg, vreg;
#define ATT_LOAD(KT) do { const int kt__ = (KT); \
        if (kt__ < ktf) { const float* kp_ = Kf + (size_t)(kt__ * 64 + lrow) * KVD + lch * 8; const float* vp_ = Vf + (size_t)(kt__ * 64 + lrow) * KVD + lch * 8; \
            const f32x4 ka_ = *(const f32x4*)kp_, kb_ = *(const f32x4*)(kp_ + 4), va_ = *(const f32x4*)vp_, vb_ = *(const f32x4*)(vp_ + 4); \
            kreg.x = cvt_pk_bf16(ka_[0], ka_[1]); kreg.y = cvt_pk_bf16(ka_[2], ka_[3]); kreg.z = cvt_pk_bf16(kb_[0], kb_[1]); kreg.w = cvt_pk_bf16(kb_[2], kb_[3]); \
            vreg.x = cvt_pk_bf16(va_[0], va_[1]); vreg.y = cvt_pk_bf16(va_[2], va_[3]); vreg.z = cvt_pk_bf16(vb_[0], vb_[1]); vreg.w = cvt_pk_bf16(vb_[2], vb_[3]); } \
        else { kreg = *(const u32x4*)(kg + (size_t)kt__ * 64 * KVD); vreg = *(const u32x4*)(vg + (size_t)kt__ * 64 * KVD); } } while (0)
    ATT_LOAD(kt_top);
    bool mydone = false; int buf = 0, it = 0;
    for (int kt = kt_top; kt >= 0; --kt, buf ^= 1, ++it) {
        *(LAS u32x4*)(wK + buf * 18432) = kreg;
#pragma unroll
        for (int e = 0; e < 4; ++e) { *(LAS unsigned short*)(wV + buf * 18432 + (2 * e) * 144) = (unsigned short)vreg[e]; *(LAS unsigned short*)(wV + buf * 18432 + (2 * e + 1) * 144) = (unsigned short)(vreg[e] >> 16); }
        if (lane == 0) flags[(it & 1) * 8 + wave] = mydone ? 1u : 0u;
        __syncthreads();
        if (kt > 0) ATT_LOAD(kt - 1);
        unsigned nd = 0;
#pragma unroll
        for (int w = 0; w < 8; ++w) nd += flags[(it & 1) * 8 + w];
        if (nd == 8u) break;
        if (mydone) continue;
        const int k0 = kt * 64;
        const LAS unsigned char* tK = rK + buf * 18432; const LAS unsigned char* tV = tK + 9216;
        f32x16 p0 = {}, p1 = {};
#pragma unroll
        for (int d0 = 0; d0 < 4; ++d0) {
            const bf16x8 k0f = *(const LAS bf16x8*)(tK + d0 * 32), k1f = *(const LAS bf16x8*)(tK + 32 * 144 + d0 * 32);
            p0 = __builtin_amdgcn_mfma_f32_32x32x16_bf16(k0f, qr[d0], p0, 0, 0, 0); p1 = __builtin_amdgcn_mfma_f32_32x32x16_bf16(k1f, qr[d0], p1, 0, 0, 0);
        }
        const bool diag = (k0 + 63 >= qpos0);
        f32x2 k0v[8], k1v[8], b0v[8], b1v[8]; float gp[8];
#pragma unroll
        for (int j = 0; j < 8; ++j) {
            f32x2 e0, e1; e0.x = __builtin_amdgcn_exp2f(p0[2 * j]); e0.y = __builtin_amdgcn_exp2f(p0[2 * j + 1]); e1.x = __builtin_amdgcn_exp2f(p1[2 * j]); e1.y = __builtin_amdgcn_exp2f(p1[2 * j + 1]);
            const f32x2 d0 = e0 + 1.0f, d1 = e1 + 1.0f;
            k0v[j].x = __builtin_amdgcn_rcpf(d0.x); k0v[j].y = __builtin_amdgcn_rcpf(d0.y); k1v[j].x = __builtin_amdgcn_rcpf(d1.x); k1v[j].y = __builtin_amdgcn_rcpf(d1.y);
            b0v[j] = 1.0f - k0v[j]; b1v[j] = 1.0f - k1v[j];
        }
        if (diag) {
#pragma unroll
            for (int r = 0; r < 16; ++r) {
                if (!(k0 + crow(r, hi) < qpos)) { if (r & 1) { k0v[r >> 1].y = 1.0f; b0v[r >> 1].y = 0.f; } else { k0v[r >> 1].x = 1.0f; b0v[r >> 1].x = 0.f; } }
                if (!(k0 + 32 + crow(r, hi) < qpos)) { if (r & 1) { k1v[r >> 1].y = 1.0f; b1v[r >> 1].y = 0.f; } else { k1v[r >> 1].x = 1.0f; b1v[r >> 1].x = 0.f; } }
            }
        }
#pragma unroll
        for (int a = 0; a < 4; ++a) { const f32x2 t0 = k0v[2 * a] * k0v[2 * a + 1], t1 = k1v[2 * a] * k1v[2 * a + 1]; gp[a] = t0.x * t0.y; gp[4 + a] = t1.x * t1.y; }
        float run = carry;
#pragma unroll
        for (int g = 7; g >= 0; --g) {
            const float other = __shfl_xor(gp[g], 32);
            float ga = (hi == 0) ? run * other : run;
            run *= gp[g] * other;
            const int a = g & 3;
            if (g < 4) {
                f32x2 gg; gg.y = ga; gg.x = ga * k0v[2 * a + 1].y; b0v[2 * a + 1] = b0v[2 * a + 1] * gg; ga = gg.x * k0v[2 * a + 1].x;
                gg.y = ga; gg.x = ga * k0v[2 * a].y; b0v[2 * a] = b0v[2 * a] * gg;
            } else {
                f32x2 gg; gg.y = ga; gg.x = ga * k1v[2 * a + 1].y; b1v[2 * a + 1] = b1v[2 * a + 1] * gg; ga = gg.x * k1v[2 * a + 1].x;
                gg.y = ga; gg.x = ga * k1v[2 * a].y; b1v[2 * a] = b1v[2 * a] * gg;
            }
        }
#pragma unroll
        for (int j = 0; j < 8; ++j) { p0[2 * j] = b0v[j].x; p0[2 * j + 1] = b0v[j].y; p1[2 * j] = b1v[j].x; p1[2 * j + 1] = b1v[j].y; }
        carry = run;
#pragma unroll
        for (int ps = 0; ps < 4; ++ps) {
            u32x4 pw;
            if (ps == 0)      { pw.x = cvt_pk_bf16(p0[0], p0[1]); pw.y = cvt_pk_bf16(p0[2], p0[3]); pw.z = cvt_pk_bf16(p0[4], p0[5]); pw.w = cvt_pk_bf16(p0[6], p0[7]); }
            else if (ps == 1) { pw.x = cvt_pk_bf16(p0[8], p0[9]); pw.y = cvt_pk_bf16(p0[10], p0[11]); pw.z = cvt_pk_bf16(p0[12], p0[13]); pw.w = cvt_pk_bf16(p0[14], p0[15]); }
            else if (ps == 2) { pw.x = cvt_pk_bf16(p1[0], p1[1]); pw.y = cvt_pk_bf16(p1[2], p1[3]); pw.z = cvt_pk_bf16(p1[4], p1[5]); pw.w = cvt_pk_bf16(p1[6], p1[7]); }
            else              { pw.x = cvt_pk_bf16(p1[8], p1[9]); pw.y = cvt_pk_bf16(p1[10], p1[11]); pw.z = cvt_pk_bf16(p1[12], p1[13]); pw.w = cvt_pk_bf16(p1[14], p1[15]); }
            const bf16x8 pb = __builtin_bit_cast(bf16x8, pw);
            const bf16x8 v0f = *(const LAS bf16x8*)(tV + ps * 32), v1f = *(const LAS bf16x8*)(tV + 32 * 144 + ps * 32);
            o0 = __builtin_amdgcn_mfma_f32_32x32x16_bf16(v0f, pb, o0, 0, 0, 0);
            o1 = __builtin_amdgcn_mfma_f32_32x32x16_bf16(v1f, pb, o1, 0, 0, 0);
        }
#if ATTN_EARLY_EXIT
        mydone = __all(carry == 0.0f);
#endif
    }
#undef ATT_LOAD
    __syncthreads();
    bf16_t* op = Op + (size_t)r32 * D + 4 * hi;
#pragma unroll
    for (int a = 0; a < 4; ++a) {
        u32x2 w0, w1; w0.x = cvt_pk_bf16(o0[4 * a], o0[4 * a + 1]); w0.y = cvt_pk_bf16(o0[4 * a + 2], o0[4 * a + 3]);
        w1.x = cvt_pk_bf16(o1[4 * a], o1[4 * a + 1]); w1.y = cvt_pk_bf16(o1[4 * a + 2], o1[4 * a + 3]);
        *(u32x2*)(op + 8 * a) = w0; *(u32x2*)(op + 32 + 8 * a) = w1;
    }
}

struct Args { const float* in[23]; float* out; unsigned char* ws; };

#if USE_XCD_BAR
#define XB_TMO      128
#define XB_XCNT(j)  (256  + 64 * (j))
#define XB_XSUB(j)  (1280 + 64 * (j))
#define XB_XGEN(j)  (2304 + 64 * (j))
#define XB_TOP      3328
#define XB_TOPGEN   3392
#define XB_SPIN_CAP (1u << 22)
__device__ __forceinline__ unsigned xb_ld(unsigned* p)              { return __hip_atomic_load(p, __ATOMIC_RELAXED, __HIP_MEMORY_SCOPE_AGENT); }
__device__ __forceinline__ unsigned xb_add(unsigned* p, unsigned v) { return __hip_atomic_fetch_add(p, v, __ATOMIC_RELAXED, __HIP_MEMORY_SCOPE_AGENT); }
__device__ __forceinline__ unsigned xb_xcc_id() { return (unsigned)__builtin_amdgcn_s_getreg((3 << 11) | 20) & 0xFu; }
#define XB_SPIN(cond, bar) do { unsigned _sp = 0; while (cond) { __builtin_amdgcn_s_sleep(1); \
    if ((++_sp & 255u) == 0u) { if (xb_ld(&(bar)[XB_TMO])) break; if (_sp > XB_SPIN_CAP) { atomicAdd(&(bar)[XB_TMO], 1u); break; } } } } while (0)
struct XcdBarrier { unsigned* bar; unsigned x; volatile LAS unsigned* st; };
__device__ __forceinline__ XcdBarrier xcd_barrier_post(unsigned* bar, volatile LAS unsigned* st) {
    XcdBarrier b; b.bar = bar; b.x = xb_xcc_id(); b.st = st;
    if (threadIdx.x == 0) (void)xb_add(&bar[XB_XCNT(b.x)], 1u);
    return b;
}
__device__ __forceinline__ void xcd_barrier_complete(unsigned* bar, unsigned x, unsigned& nloc, unsigned& nx) {
    const unsigned G = gridDim.x * gridDim.y * gridDim.z;
    unsigned sum, cnt, mine, sp = 0u;
    for (;;) {
        sum = 0u; cnt = 0u; mine = 0u;
#pragma unroll
        for (unsigned j = 0; j < 16; ++j) { const unsigned c = xb_ld(&bar[XB_XCNT(j)]); sum += c; cnt += (c > 0u) ? 1u : 0u; mine = (j == x) ? c : mine; }
        if (sum == G) break;
        __builtin_amdgcn_s_sleep(1);
        if ((++sp & 255u) == 0u) { if (xb_ld(&bar[XB_TMO])) break; if (sp > XB_SPIN_CAP) { atomicAdd(&bar[XB_TMO], 1u); break; } }
    }
    nloc = mine > 0u ? mine : 1u; nx = cnt > 0u ? cnt : 1u;
}
__device__ __forceinline__ void xcd_barrier(const XcdBarrier& b) {
    asm volatile("s_waitcnt vmcnt(0)" ::: "memory");
    __syncthreads();
    if (threadIdx.x == 0) {
        unsigned* bar = b.bar;
        __builtin_amdgcn_s_waitcnt(0);
        unsigned nloc = b.st[0], nx = b.st[1];
        if (nloc == 0u) { xcd_barrier_complete(bar, b.x, nloc, nx); b.st[0] = nloc; b.st[1] = nx; }
        const unsigned old = xb_add(&bar[XB_XSUB(b.x)], 1u);
        const unsigned gen = old / nloc;
        if (old + 1u == (gen + 1u) * nloc) {
            __builtin_amdgcn_fence(__ATOMIC_RELEASE, "agent");
            asm volatile("s_waitcnt vmcnt(0)" ::: "memory");
            const unsigned og = xb_add(&bar[XB_TOP], 1u);
            const unsigned tg = og / nx;
            if (og + 1u == (tg + 1u) * nx) xb_add(&bar[XB_TOPGEN], 1u);
            else XB_SPIN(xb_ld(&bar[XB_TOPGEN]) == tg, bar);
            __builtin_amdgcn_fence(__ATOMIC_ACQUIRE, "agent");
            xb_add(&bar[XB_XGEN(b.x)], 1u);
            asm volatile("s_waitcnt vmcnt(0)" ::: "memory");
        } else {
            XB_SPIN(xb_ld(&bar[XB_XGEN(b.x)]) == gen, bar);
            __builtin_amdgcn_fence(__ATOMIC_ACQUIRE, "agent");
            asm volatile("s_waitcnt vmcnt(0)" ::: "memory");
        }
    }
    __syncthreads();
}
#endif

constexpr int LDS_BYTES = 147456, RING_BYTES = 131072, MISC_OFF = RING_BYTES + 320;

__device__ __forceinline__ void tr_item(const float* __restrict__ W, int ldw, int k0, int nsrc0, const float* __restrict__ gain, bf16_t* WT, int ldt, int drow0, LAS float* scr, int lane, bool vperm) {
    { float v[32]; const float gv = gain ? gain[k0 + lane] : 1.0f;
#pragma unroll
      for (int i = 0; i < 32; ++i) v[i] = W[(size_t)(k0 + 2 * i + (lane >> 5)) * ldw + nsrc0 + (lane & 31)];
      __builtin_amdgcn_sched_barrier(0);
#pragma unroll
      for (int i = 0; i < 32; ++i) { const int kk = 2 * i + (lane >> 5); scr[kk * 33 + (lane & 31)] = v[i] * __shfl(gv, kk); } }
    LDS_WAIT(); asm volatile("" ::: "memory");
    const int c = lane & 7;
    int kk[8];
#pragma unroll
    for (int e = 0; e < 8; ++e) kk[e] = vperm ? (16 * (c >> 1) + 8 * (e >> 2) + 4 * (c & 1) + (e & 3)) : (8 * c + e);
#pragma unroll
    for (int j = 0; j < 4; ++j) { const int n = (lane >> 3) + 8 * j; const LAS float* s = scr + n;
        u32x4 o; o.x = cvt_pk_bf16(s[kk[0] * 33], s[kk[1] * 33]); o.y = cvt_pk_bf16(s[kk[2] * 33], s[kk[3] * 33]); o.z = cvt_pk_bf16(s[kk[4] * 33], s[kk[5] * 33]); o.w = cvt_pk_bf16(s[kk[6] * 33], s[kk[7] * 33]);
        *(u32x4*)(WT + (size_t)(drow0 + n) * ldt + k0 + 8 * c) = o; }
    LDS_WAIT(); asm volatile("" ::: "memory");
}
__device__ __forceinline__ int glu_src(int drow0, int half) { const int pn = drow0 >> 8, j = drow0 & 255; return j < 128 ? pn * 128 + j : half + pn * 128 + (j - 128); }

template <int I> __device__ __forceinline__ void dw_step(f32x2 (&acc)[32], const f32x2 (&wv)[CW], const LAS unsigned char* base) {
    const unsigned pk = *(const LAS unsigned*)(base + I * 2048);
    const f32x2 in = (f32x2){__uint_as_float(pk << 16), __uint_as_float(pk & 0xffff0000u)};
    constexpr int TLO = (I - 30 > 0) ? I - 30 : 0, THI = (I < 31) ? I : 31;
#pragma unroll
    for (int t = TLO; t <= THI; ++t) acc[t] += wv[I - t] * in;
    if constexpr ((I & 7) == 7) __builtin_amdgcn_sched_barrier(0);
    if constexpr (I + 1 < 62) dw_step<I + 1>(acc, wv, base);
}

__global__ void __launch_bounds__(512) yoco_fwd(Args args) {
    extern __shared__ __attribute__((aligned(16))) unsigned char lds_raw[];
    LAS unsigned char* lds = (LAS unsigned char*)lds_raw;
    int tid = threadIdx.x, lane = tid & 63, wave = __builtin_amdgcn_readfirstlane(tid >> 6);
#define RELAUNDER() do { tid = threadIdx.x; asm volatile("" : "+v"(tid)); lane = tid & 63; wave = __builtin_amdgcn_readfirstlane(tid >> 6); } while (0)
    const int G = gridDim.x, bx = blockIdx.x;
    unsigned char* ws = args.ws;
    float* out = args.out;
    const float* x_p = args.in[0]; const float* x_s = args.in[1]; const float* state_conv = args.in[2]; const float* cache_k = args.in[3]; const float* cache_v = args.in[4];
    const float* a_norm_g = args.in[5]; const float* conv_w_in = args.in[6]; const float* conv_b_in = args.in[7]; const float* conv_w_dw = args.in[8]; const float* conv_b_dw = args.in[9];
    const float* conv_ln_g = args.in[10]; const float* conv_ln_b = args.in[11]; const float* conv_w_out = args.in[12]; const float* conv_b_out = args.in[13];
    const float* kv_norm_g = args.in[14]; const float* w_kv = args.in[15]; const float* b_norm_g = args.in[16]; const float* w_q = args.in[17]; const float* w_o = args.in[18];
    const float* ffn_norm_g = args.in[19]; const float* ffn_w_gu = args.in[20]; const float* ffn_w_down = args.in[21]; const float* final_norm_g = args.in[22];
    float* ss = (float*)(ws + WS_SS);
    bf16_t* Wt_in = (bf16_t*)(ws + WS_WIN); bf16_t* Wt_out = (bf16_t*)(ws + WS_WOUT); bf16_t* Wt_gu0 = (bf16_t*)(ws + WS_WGU0); bf16_t* Wt_gu1 = (bf16_t*)(ws + WS_WGU1);
    bf16_t* Wt_d0 = (bf16_t*)(ws + WS_WD0); bf16_t* Wt_d1 = (bf16_t*)(ws + WS_WD1); bf16_t* Wt_kvq = (bf16_t*)(ws + WS_WKVQ); bf16_t* Wt_o = (bf16_t*)(ws + WS_WO);
    bf16_t* Kp = (bf16_t*)(ws + WS_KP); bf16_t* Ks = (bf16_t*)(ws + WS_KS); bf16_t* Vtp = (bf16_t*)(ws + WS_VTP); bf16_t* Vts = (bf16_t*)(ws + WS_VTS);
    bf16_t* S1 = (bf16_t*)(ws + WS_S1); bf16_t* S2 = (bf16_t*)(ws + WS_S2); bf16_t* S3 = (bf16_t*)(ws + WS_S3); bf16_t* HID = (bf16_t*)(ws + WS_HID);
    float* R = out + O_Y;

    cg::grid_group grid = cg::this_grid();
#if USE_XCD_BAR
    { volatile LAS unsigned* misc = (volatile LAS unsigned*)(lds + MISC_OFF); if (tid < 32) misc[tid] = 0u; }
    __syncthreads();
    XcdBarrier xbar = xcd_barrier_post((unsigned*)(ws + WS_CTL), (volatile LAS unsigned*)(lds + MISC_OFF) + 8);
#define GRID_BAR() xcd_barrier(xbar)
#else
#define GRID_BAR() grid.sync()
#endif

    for (int rep_ = 0; rep_ < REP_P0; ++rep_) {
        RELAUNDER();
        LAS float* scr = (LAS float*)(lds + wave * 16384);
        const int gw = bx * 8 + wave, NGW = G * 8;
        constexpr int I_IN = 16 * 64, I_OUT = 16 * 32, I_GU = 16 * 176, I_DN = 44 * 32, I_KV = 16 * 16, I_Q = 16 * 32, I_O = 16 * 32;
        constexpr int NITEMS = I_IN + I_OUT + 2 * I_GU + 2 * I_DN + I_KV + I_Q + I_O;
        for (int it = gw; it < NITEMS; it += NGW) {
            int r = it;
            if (r < I_IN) { const int kb = r >> 6, nb = r & 63; tr_item(conv_w_in, 2 * D, 64 * kb, glu_src(32 * nb, D), a_norm_g, Wt_in, D, 32 * nb, scr, lane, false); continue; } r -= I_IN;
            if (r < I_OUT) { const int kb = r >> 5, nb = r & 31; tr_item(conv_w_out, D, 64 * kb, 32 * nb, nullptr, Wt_out, D, 32 * nb, scr, lane, false); continue; } r -= I_OUT;
            if (r < 2 * I_GU) { const int l = r / I_GU, q = r % I_GU, kb = q / 176, nb = q % 176;
                tr_item(ffn_w_gu + (size_t)l * D * 2 * DFF, 2 * DFF, 64 * kb, glu_src(32 * nb, DFF), ffn_norm_g + l * D, l ? Wt_gu1 : Wt_gu0, D, 32 * nb, scr, lane, false); continue; } r -= 2 * I_GU;
            if (r < 2 * I_DN) { const int l = r / I_DN, q = r % I_DN, kb = q >> 5, nb = q & 31;
                tr_item(ffn_w_down + (size_t)l * DFF * D, D, 64 * kb, 32 * nb, nullptr, l ? Wt_d1 : Wt_d0, DFF, 32 * nb, scr, lane, false); continue; } r -= 2 * I_DN;
            if (r < I_KV) { const int kb = r >> 4, nb = r & 15; tr_item(w_kv, 2 * KVD, 64 * kb, 32 * nb, kv_norm_g, Wt_kvq, D, 32 * nb, scr, lane, false); continue; } r -= I_KV;
            if (r < I_Q) { const int kb = r >> 5, nb = r & 31; tr_item(w_q, D, 64 * kb, 32 * nb, b_norm_g, Wt_kvq, D, 512 + 32 * nb, scr, lane, false); continue; } r -= I_Q;
            { const int kb = r >> 5, nb = r & 31; tr_item(w_o, D, 64 * kb, 32 * nb, nullptr, Wt_o, D, 32 * nb, scr, lane, false); }
        }
        for (int row0 = gw * 4; row0 < T; row0 += NGW * 4) {
            f32x4 v[4][4]; float sq[4];
#pragma unroll
            for (int rr = 0; rr < 4; ++rr) { const int row = row0 + rr; const float* src = row < T_P ? x_p + (size_t)row * D : x_s + (size_t)(row - T_P) * D;
#pragma unroll
                for (int j = 0; j < 4; ++j) v[rr][j] = *(const f32x4*)(src + 4 * (lane + 64 * j)); }
            __builtin_amdgcn_sched_barrier(0);
#pragma unroll
            for (int rr = 0; rr < 4; ++rr) { float q = 0.f;
#pragma unroll
                for (int j = 0; j < 4; ++j) q += (v[rr][j][0] * v[rr][j][0] + v[rr][j][1] * v[rr][j][1]) + (v[rr][j][2] * v[rr][j][2] + v[rr][j][3] * v[rr][j][3]);
                sq[rr] = q; }
#pragma unroll
            for (int o = 1; o < 64; o <<= 1) {
#pragma unroll
                for (int rr = 0; rr < 4; ++rr) sq[rr] += __shfl_xor(sq[rr], o); }
#pragma unroll
            for (int rr = 0; rr < 4; ++rr) { const int row = row0 + rr;
                if (lane == 0) ss[row] = sq[rr];
#pragma unroll
                for (int j = 0; j < 4; ++j) { u32x2 w; w.x = cvt_pk_bf16(v[rr][j][0], v[rr][j][1]); w.y = cvt_pk_bf16(v[rr][j][2], v[rr][j][3]); *(u32x2*)(S3 + (size_t)row * D + 4 * (lane + 64 * j)) = w; } }
        }
        const int gt = bx * 512 + tid, NT = G * 512;
        for (int i = gt; i < 4 * T; i += NT) ss[T + i] = 0.f;
    }
    grid.sync();

    { pg8::Gemm g{S3, Wt_in, T_P, 2 * D, D}; pg8::StaticOrder S; S.init(T_P, 2 * D, G, bx);
      EpiGlu<0> E{S2, D, ss, conv_b_in, out + O_CSP, out + O_CSS};
      pg8::gemm_phase<EpiGlu<0>, pg8::StaticOrder, true>(lds, g, S, E);
      RELAUNDER(); { SEpiGlu<0> SE{S2, D, ss, conv_b_in, out + O_CSS}; sg32_phase<2, 4>(S3, Wt_in, D, D / 32, SE, lds, bx, G, wave, lane); } }
    GRID_BAR();

    for (int rep_ = 0; rep_ < REP_P2; ++rep_) {
        RELAUNDER();
        f32x2 wv[CW];
#pragma unroll
        for (int j = 0; j < CW; ++j) wv[j] = *(const f32x2*)(conv_w_dw + (size_t)j * D + 2 * tid);
        const f32x2 bdw = *(const f32x2*)(conv_b_dw + 2 * tid);
        if (wave < 2) for (int tok = bx * 2 + wave; tok < T_S; tok += 2 * G) {
            const int b = tok >> 6, t = tok & (DSEQ - 1), c0 = 8 * lane;
            float a[16];
            { const f32x4 b0 = *(const f32x4*)(conv_b_dw + c0), b1 = *(const f32x4*)(conv_b_dw + c0 + 4), b2 = *(const f32x4*)(conv_b_dw + 512 + c0), b3 = *(const f32x4*)(conv_b_dw + 512 + c0 + 4);
#pragma unroll
              for (int e = 0; e < 4; ++e) { a[e] = b0[e]; a[4 + e] = b1[e]; a[8 + e] = b2[e]; a[12 + e] = b3[e]; } }
#pragma unroll 1
            for (int j = 0; j < CW; ++j) {
                const int tt = t - CST + j;
                float in[16];
                if (tt >= 0) {
                    const bf16_t* src = S2 + (size_t)(T_P + b * DSEQ + tt) * D + c0;
                    const u32x4 p0 = *(const u32x4*)src, p1 = *(const u32x4*)(src + 512);
#pragma unroll
                    for (int e = 0; e < 4; ++e) { in[2 * e] = __uint_as_float(p0[e] << 16); in[2 * e + 1] = __uint_as_float(p0[e] & 0xffff0000u); in[8 + 2 * e] = __uint_as_float(p1[e] << 16); in[8 + 2 * e + 1] = __uint_as_float(p1[e] & 0xffff0000u); }
                } else {
                    const float* src = state_conv + ((size_t)(b * CST + CST + tt) * D + c0);
                    const f32x4 q0 = *(const f32x4*)src, q1 = *(const f32x4*)(src + 4), q2 = *(const f32x4*)(src + 512), q3 = *(const f32x4*)(src + 516);
#pragma unroll
                    for (int e = 0; e < 4; ++e) { in[e] = q0[e]; in[4 + e] = q1[e]; in[8 + e] = q2[e]; in[12 + e] = q3[e]; }
                }
                const float* wp = conv_w_dw + (size_t)j * D + c0;
                const f32x4 w0 = *(const f32x4*)wp, w1 = *(const f32x4*)(wp + 4), w2 = *(const f32x4*)(wp + 512), w3 = *(const f32x4*)(wp + 516);
#pragma unroll
                for (int e = 0; e < 4; ++e) { a[e] += w0[e] * in[e]; a[4 + e] += w1[e] * in[4 + e]; a[8 + e] += w2[e] * in[8 + e]; a[12 + e] += w3[e] * in[12 + e]; }
            }
            float s = 0.f;
#pragma unroll
            for (int e = 0; e < 16; ++e) s += a[e];
            const float mean = wave_sum(s) * (1.0f / D); float q = 0.f;
#pragma unroll
            for (int e = 0; e < 16; ++e) { a[e] -= mean; q += a[e] * a[e]; }
            const float rstd = __builtin_amdgcn_rsqf(wave_sum(q) * (1.0f / D) + EPS);
#pragma unroll
            for (int hh = 0; hh < 2; ++hh) {
                const int c = hh * 512 + c0; float y[8];
#pragma unroll
                for (int e = 0; e < 8; ++e) { const float v = a[hh * 8 + e] * rstd * conv_ln_g[c + e] + conv_ln_b[c + e]; y[e] = v * fast_sigmoid(v); }
                u32x4 w; w.x = cvt_pk_bf16(y[0], y[1]); w.y = cvt_pk_bf16(y[2], y[3]); w.z = cvt_pk_bf16(y[4], y[5]); w.w = cvt_pk_bf16(y[6], y[7]);
                *(u32x4*)(S1 + (size_t)(T_P + tok) * D + c) = w;
            }
        }
        constexpr int NTILE = T_P / 32;
        u32x4 tv[16];
        const int li0 = tid >> 7, lcc = tid & 127;
#define DW_LOAD(TILE) do { const bf16_t* p_ = S2 + ((long)((TILE) >> 6) * SEQ + ((TILE) & 63) * 32 - CST + li0) * D + 8 * lcc; \
        _Pragma("unroll") for (int q = 0; q < 16; ++q) { if (q < 15 || li0 < 2) tv[q] = *(const u32x4*)(p_ + (long)q * 4 * D); } \
        if ((((TILE) & 63) == 0)) { _Pragma("unroll") for (int q = 0; q < 8; ++q) if (li0 + 4 * q < CST) tv[q] = (u32x4){0u, 0u, 0u, 0u}; } } while (0)
        for (int tile = bx; tile < NTILE; tile += G) {
            const int b = tile >> 6, t0 = (tile & 63) * 32, rowbase = b * SEQ;
            DW_LOAD(tile);
            __builtin_amdgcn_sched_barrier(0);
#pragma unroll
            for (int q = 0; q < 16; ++q) { if (q < 15 || li0 < 2) *(LAS u32x4*)(lds + li0 * 2048 + lcc * 16 + q * 8192) = tv[q]; }
            __syncthreads();
            f32x2 acc[32];
#pragma unroll
            for (int t = 0; t < 32; ++t) acc[t] = (f32x2){0.f, 0.f};
            dw_step<0>(acc, wv, lds + tid * 4);
            __syncthreads();
#pragma unroll
            for (int t = 0; t < 32; ++t) *(LAS f32x2*)(lds + t * 4096 + tid * 8) = acc[t];
            __syncthreads();
#pragma unroll 1
            for (int th = 0; th < 2; ++th) {
            f32x4 v[2][4]; float s4[2]; f32x4 lng[4], lnb[4];
#pragma unroll
            for (int j = 0; j < 4; ++j) { lng[j] = *(const f32x4*)(conv_ln_g + 4 * (lane + 64 * j)); lnb[j] = *(const f32x4*)(conv_ln_b + 4 * (lane + 64 * j)); }
#pragma unroll
            for (int tt = 0; tt < 2; ++tt) { float sa = 0.f;
#pragma unroll
                for (int j = 0; j < 4; ++j) { v[tt][j] = *(const LAS f32x4*)(lds + (wave * 4 + th * 2 + tt) * 4096 + (lane + 64 * j) * 16) + *(const f32x4*)(conv_b_dw + 4 * (lane + 64 * j)); sa += (v[tt][j][0] + v[tt][j][1]) + (v[tt][j][2] + v[tt][j][3]); }
                s4[tt] = sa; }
#pragma unroll
            for (int o = 1; o < 64; o <<= 1) {
#pragma unroll
                for (int tt = 0; tt < 2; ++tt) s4[tt] += __shfl_xor(s4[tt], o); }
#pragma unroll
            for (int tt = 0; tt < 2; ++tt) { const float mean = s4[tt] * (1.0f / D); float q = 0.f;
#pragma unroll
                for (int j = 0; j < 4; ++j) { v[tt][j] = v[tt][j] - mean; q += (v[tt][j][0] * v[tt][j][0] + v[tt][j][1] * v[tt][j][1]) + (v[tt][j][2] * v[tt][j][2] + v[tt][j][3] * v[tt][j][3]); }
                s4[tt] = q; }
#pragma unroll
            for (int o = 1; o < 64; o <<= 1) {
#pragma unroll
                for (int tt = 0; tt < 2; ++tt) s4[tt] += __shfl_xor(s4[tt], o); }
#pragma unroll
            for (int tt = 0; tt < 2; ++tt) {
                const float rstd = __builtin_amdgcn_rsqf(s4[tt] * (1.0f / D) + EPS);
#pragma unroll
                for (int j = 0; j < 4; ++j) {
                    f32x4 y = v[tt][j] * rstd * lng[j] + lnb[j];
#pragma unroll
                    for (int e = 0; e < 4; ++e) y[e] = y[e] * fast_sigmoid(y[e]);
                    u32x2 w; w.x = cvt_pk_bf16(y[0], y[1]); w.y = cvt_pk_bf16(y[2], y[3]);
                    *(u32x2*)(S1 + (size_t)(rowbase + t0 + wave * 4 + th * 2 + tt) * D + 4 * (lane + 64 * j)) = w;
                }
            }
            }
            __syncthreads();
        }
#undef DW_LOAD
    }
    GRID_BAR();

    { pg8::Gemm g{S1, Wt_out, T_P, D, D}; pg8::StaticOrder S; S.init(T_P, D, G, bx);
      EpiRes<0> E{x_p, x_s, S3, S2, ss + T, conv_b_out};
      pg8::gemm_phase<EpiRes<0>, pg8::StaticOrder, true>(lds, g, S, E);
      RELAUNDER(); { SEpiRes<0> SE{x_s, S3, S2, ss + T, conv_b_out}; sg32_phase<1, 4>(S1, Wt_out, D, D / 32, SE, lds, bx, G, wave, lane); } }
    GRID_BAR();
    for (int rep_ = 0; rep_ < REP_P4; ++rep_) { pg8::Gemm g{S2, Wt_gu0, T_P, 2 * DFF, D}; pg8::StaticOrder S; S.init(T_P, 2 * DFF, G, bx);
      EpiGlu<1> E{HID, DFF, ss + T, nullptr, nullptr, nullptr};
      pg8::gemm_phase<EpiGlu<1>, pg8::StaticOrder, true>(lds, g, S, E);
      RELAUNDER(); for (int r2_ = 0; r2_ < REP_SG; ++r2_) { SEpiGlu<1> SE{HID, DFF, ss + T, nullptr, nullptr}; sg32_phase<2, 1>(S2, Wt_gu0, D, DFF / 32, SE, lds, bx, G, wave, lane); } }
    GRID_BAR();
    { pg8::Gemm g{HID, Wt_d0, T_P, D, DFF}; pg8::StaticOrder S; S.init(T_P, D, G, bx);
      EpiRes<1> E{nullptr, nullptr, S2, S1, ss + 2 * T, nullptr};
      pg8::gemm_phase<EpiRes<1>, pg8::StaticOrder, true>(lds, g, S, E);
      RELAUNDER(); { SEpiRes<1> SE{nullptr, S2, S1, ss + 2 * T, nullptr}; sg32_phase<1, 4>(HID, Wt_d0, DFF, D / 32, SE, lds, bx, G, wave, lane); } }
    GRID_BAR();
    { pg8::Gemm g{S1, Wt_kvq, T_P, 6 * 256, D}; pg8::StaticOrder S; S.init(T_P, 6 * 256, G, bx);
      EpiKvq E{ss + 2 * T, out, Kp, Ks, Vtp, Vts, S2};
      pg8::gemm_phase<EpiKvq, pg8::StaticOrder, true>(lds, g, S, E);
      RELAUNDER(); { SEpiKvq SE{ss + 2 * T, out, Ks, Vts, S2}; sg32_phase<1, 2>(S1, Wt_kvq, D, 1536 / 32, SE, lds, bx, G, wave, lane); } }
    GRID_BAR();
    for (int rep_ = 0; rep_ < REP_P7; ++rep_) {
        RELAUNDER();
        constexpr int NU_S = NB_S * 4, NU = NU_S + NB_P * 4 * 32;
        for (int L = bx; L < NU; L += G) {
            const int h4 = wave & 3, sub = wave >> 2;
            if (L < NU_S) {
                const int b = L >> 2, kvh = L & 3, h = kvh * 4 + h4, q0 = sub * 32;
                const size_t row0 = (size_t)T_P + b * DSEQ + q0;
                attn_unit(S2 + row0 * D + h * 64, Ks + (size_t)b * SKV_S * KVD + kvh * 64, Vts + (size_t)b * SKV_S * KVD + kvh * 64, SKV_S, PAST + q0, PAST / 64, S3 + row0 * D + h * 64, lds, tid, lane, wave, cache_k + (size_t)b * PAST * KVD + kvh * 64, cache_v + (size_t)b * PAST * KVD + kvh * 64, PAST / 64);
            } else {
                const int L2 = L - NU_S, qb = 31 - (L2 >> 6), bk = L2 & 63, b = bk >> 2, kvh = bk & 3, h = kvh * 4 + h4, q0 = qb * 64 + sub * 32;
                const size_t row0 = (size_t)b * SEQ + q0;
                attn_unit(S2 + row0 * D + h * 64, Kp + (size_t)b * SEQ * KVD + kvh * 64, Vtp + (size_t)b * SEQ * KVD + kvh * 64, SEQ, q0, qb, S3 + row0 * D + h * 64, lds, tid, lane, wave, nullptr, nullptr, 0);
            }
        }
    }
    GRID_BAR();
    { pg8::Gemm g{S3, Wt_o, T_P, D, D}; pg8::StaticOrder S; S.init(T_P, D, G, bx);
      EpiRes<1> E{nullptr, nullptr, S1, S2, ss + 3 * T, nullptr};
      pg8::gemm_phase<EpiRes<1>, pg8::StaticOrder, true>(lds, g, S, E);
      RELAUNDER(); { SEpiRes<1> SE{nullptr, S1, S2, ss + 3 * T, nullptr}; sg32_phase<1, 4>(S3, Wt_o, D, D / 32, SE, lds, bx, G, wave, lane); } }
    GRID_BAR();
    { pg8::Gemm g{S2, Wt_gu1, T_P, 2 * DFF, D}; pg8::StaticOrder S; S.init(T_P, 2 * DFF, G, bx);
      EpiGlu<1> E{HID, DFF, ss + 3 * T, nullptr, nullptr, nullptr};
      pg8::gemm_phase<EpiGlu<1>, pg8::StaticOrder, true>(lds, g, S, E);
      RELAUNDER(); { SEpiGlu<1> SE{HID, DFF, ss + 3 * T, nullptr, nullptr}; sg32_phase<2, 1>(S2, Wt_gu1, D, DFF / 32, SE, lds, bx, G, wave, lane); } }
    GRID_BAR();
    { pg8::Gemm g{HID, Wt_d1, T_P, D, DFF}; pg8::StaticOrder S; S.init(T_P, D, G, bx);
      EpiRes<2> E{nullptr, nullptr, S2, S2, ss + 4 * T, nullptr};
      pg8::gemm_phase<EpiRes<2>, pg8::StaticOrder, true>(lds, g, S, E);
      RELAUNDER(); { SEpiRes<2> SE{nullptr, S2, S2, ss + 4 * T, nullptr}; sg32_phase<1, 4>(HID, Wt_d1, DFF, D / 32, SE, lds, bx, G, wave, lane); } }
    GRID_BAR();
    {
        RELAUNDER();
        const int gw = bx * 8 + wave, NGW = G * 8;
        for (int row = gw; row < T; row += NGW) {
            const float rs = __builtin_amdgcn_rsqf(ss[4 * T + row] * (1.0f / D) + EPS);
#pragma unroll
            for (int j = 0; j < 4; ++j) { const int c = 4 * (lane + 64 * j); const u32x2 pk = *(const u32x2*)(S2 + (size_t)row * D + c); const f32x4 gg = *(const f32x4*)(final_norm_g + c);
                const f32x4 v = (f32x4){__uint_as_float(pk.x << 16), __uint_as_float(pk.x & 0xffff0000u), __uint_as_float(pk.y << 16), __uint_as_float(pk.y & 0xffff0000u)};
                *(f32x4*)(R + (size_t)row * D + c) = v * rs * gg; }
        }
    }
}

extern "C" void kernel_launch(void* const* d_in, const int* in_sizes, int n_in, void* d_out, int out_size, void* d_ws, size_t ws_size, hipStream_t stream) {
    static int grid = 0;
    if (grid == 0) {
        if (n_in != 23 || ws_size < WS_END) { fprintf(stderr, "kernel_launch: unexpected n_in %d / ws_size %zu\n", n_in, ws_size); grid = -1; return; }
        int dev = 0, cus = 0, per_cu = 0;
        (void)hipGetDevice(&dev); (void)hipDeviceGetAttribute(&cus, hipDeviceAttributeMultiprocessorCount, dev);
        if (hipFuncSetAttribute((const void*)yoco_fwd, hipFuncAttributeMaxDynamicSharedMemorySize, LDS_BYTES) != hipSuccess) { fprintf(stderr, "kernel_launch: hipFuncSetAttribute failed\n"); grid = -1; return; }
        if (hipOccupancyMaxActiveBlocksPerMultiprocessor(&per_cu, (const void*)yoco_fwd, 512, LDS_BYTES) != hipSuccess || per_cu < 1) { fprintf(stderr, "kernel_launch: occupancy query says %d\n", per_cu); per_cu = 1; }
        (void)hipGetLastError();
        grid = cus * 1;
    }
    if (grid < 0) return;
    (void)hipMemsetAsync((char*)d_ws + WS_CTL, 0, CTL_BYTES, stream);
    Args a{};
    for (int i = 0; i < 23; ++i) a.in[i] = (const float*)d_in[i];
    a.out = (float*)d_out; a.ws = (unsigned char*)d_ws;
    void* kargs[] = {&a};
    hipError_t e = hipLaunchCooperativeKernel((const void*)yoco_fwd, dim3(grid), dim3(512), kargs, LDS_BYTES, stream);
    if (e != hipSuccess) fprintf(stderr, "kernel_launch: cooperative launch failed: %s (grid %d)\n", hipGetErrorString(e), grid);
}
```

```cpp
#include <hip/hip_runtime.h>
#include <hip/hip_cooperative_groups.h>
#include <cstdio>
#include <cstdint>
namespace cg = cooperative_groups;

#ifndef USE_XCD_BAR
#define USE_XCD_BAR 1
#endif
#ifndef REP_P0
#define REP_P0 1
#endif
#ifndef REP_P2
#define REP_P2 1
#endif
#ifndef REP_P4
#define REP_P4 1
#endif
#ifndef REP_P7
#define REP_P7 1
#endif
#ifndef REP_EPI_GLU
#define REP_EPI_GLU 1
#endif
#ifndef REP_SG
#define REP_SG 1
#endif
#ifndef ATTN_EARLY_EXIT
#define ATTN_EARLY_EXIT 1
#endif

#define LAS __attribute__((address_space(3)))
#define GAS __attribute__((address_space(1)))
typedef unsigned short bf16_t;
typedef short bf16x8 __attribute__((ext_vector_type(8)));
typedef float f32x4 __attribute__((ext_vector_type(4)));
typedef float f32x2 __attribute__((ext_vector_type(2)));
typedef float f32x16 __attribute__((ext_vector_type(16)));
typedef unsigned u32x4 __attribute__((ext_vector_type(4)));
typedef unsigned u32x2 __attribute__((ext_vector_type(2)));

constexpr int D = 1024, SEQ = 2048, NB_P = 16, NB_S = 8, DSEQ = 64, PAST = 2048, SKV_S = PAST + DSEQ;
constexpr int T_P = NB_P * SEQ, T_S = NB_S * DSEQ, T = T_P + T_S;
constexpr int DFF = 2816, CW = 31, CST = 30, KVD = 256;
constexpr float EPS = 1e-6f;
constexpr float QSCALE = 0.125f * 1.4426950408889634f;
constexpr size_t O_Y = 0, O_CSP = (size_t)T * D, O_KP = O_CSP + (size_t)NB_P * CST * D, O_VP = O_KP + (size_t)T_P * KVD,
                 O_CSS = O_VP + (size_t)T_P * KVD, O_KS = O_CSS + (size_t)NB_S * CST * D, O_VS = O_KS + (size_t)T_S * KVD;
constexpr size_t MiB = 1u << 20;
constexpr size_t WS_CTL = 0, WS_SS = 1 * MiB, WS_WIN = 2 * MiB, WS_WOUT = 6 * MiB, WS_WGU0 = 8 * MiB, WS_WGU1 = 19 * MiB, WS_WD0 = 30 * MiB, WS_WD1 = 36 * MiB,
                 WS_WKVQ = 42 * MiB, WS_WO = 45 * MiB, WS_KP = 47 * MiB, WS_KS = 63 * MiB, WS_VTP = 72 * MiB, WS_VTS = 88 * MiB,
                 WS_S1 = 97 * MiB, WS_S2 = 162 * MiB, WS_HID = 227 * MiB, WS_S3 = 406 * MiB, WS_END = 471 * MiB;
constexpr size_t CTL_BYTES = 64 * 1024;

typedef __bf16 bf16x2_t __attribute__((ext_vector_type(2)));
__device__ __forceinline__ unsigned cvt_pk_bf16(float lo, float hi) { const f32x2 v = {lo, hi}; const bf16x2_t b = __builtin_convertvector(v, bf16x2_t); return __builtin_bit_cast(unsigned, b); }
__device__ __forceinline__ float fast_sigmoid(float x) { return __builtin_amdgcn_rcpf(1.0f + __builtin_amdgcn_exp2f(-1.4426950408889634f * x)); }
__device__ __forceinline__ float wave_sum(float v) {
#pragma unroll
    for (int o = 1; o < 64; o <<= 1) v += __shfl_xor(v, o);
    return v;
}
#define LDS_WAIT() asm volatile("s_waitcnt lgkmcnt(0)" ::: "memory")

namespace pg8 {
#define PG8_LAS __attribute__((address_space(3)))
constexpr int BM = 256, BK = 64, HALF = 128, HTB = HALF * BK * 2, STAGE_BYTES = 8 * HTB, NXCD = 8, WGM = 8;
__host__ __device__ __forceinline__ int lds_byte(int r, int c) { const int st = (r >> 4) * 2 + (c >> 5), rr = r & 15, cc = c & 31, ob = rr * 64 + cc * 2; return st * 1024 + (ob ^ (((ob >> 9) & 1) << 5)); }
__host__ __device__ __forceinline__ void stage_rc(int b, int& R, int& C) { const int st = b / 1024, sb = b % 1024, swz = sb ^ (((sb >> 9) & 1) << 5); R = (st >> 1) * 16 + swz / 64; C = (st & 1) * 32 + (swz % 64) / 2; }
__host__ __device__ __forceinline__ int perm32(int rho) { const int n = rho >> 4, i = rho & 15; return 8 * (i >> 2) + 4 * n + (i & 3); }
struct Unit { int pm, pn; };
struct Gemm { const bf16_t* A; const bf16_t* Bt; int M, N, K; };
struct StaticOrder {
    int nM, nN, nwg, G, c;
    __host__ __device__ void init(int M, int N, int G_, int c_) { nM = M / BM; nN = N / BM; nwg = nM * nN; G = G_; c = c_; }
    __host__ __device__ bool next(int i, Unit& u) const {
        const long L = (long)i * G + c; if (L >= nwg) return false;
        int wgid = (int)L; { const int q = nwg / NXCD, r = nwg % NXCD, xcd = wgid % NXCD, off = wgid / NXCD; wgid = (xcd < r ? xcd * (q + 1) : r * (q + 1) + (xcd - r) * q) + off; }
        const int nig = WGM * nN, gid = wgid / nig, fm = gid * WGM, gsz = (nM - fm) < WGM ? (nM - fm) : WGM;
        u.pm = fm + ((wgid % nig) % gsz); u.pn = (wgid % nig) / gsz; return true;
    }
    __device__ __forceinline__ void a_ready(const Unit&) const {}
    __device__ __forceinline__ void done(const Unit&) const {}
};

template <class Epi, class Sched, bool ALIGN_EPI = false>
__device__ __forceinline__ void gemm_phase(PG8_LAS unsigned char* lds, const Gemm g, const Sched& S, const Epi& E) {
    int tid_ = threadIdx.x; asm volatile("" : "+v"(tid_));
    const int tid = tid_, wid = __builtin_amdgcn_readfirstlane(tid >> 6), lane = tid & 63, wr = wid >> 2, wc = wid & 3, fr = lane & 15, fq = lane >> 4;
    const int K = g.K, nt = K / BK;
    unsigned voffA[2], voffB[2];
#pragma unroll
    for (int i = 0; i < 2; ++i) { int R, C; stage_rc(tid * 16 + i * 8192, R, C); const int Rb = Epi::PERM ? ((R & ~31) + perm32(R & 31)) : R;
        voffA[i] = (unsigned)(R * K + C) * 2u; voffB[i] = (unsigned)(Rb * K + C) * 2u; }
    const size_t kstep = (size_t)(BK * 2);
    const size_t hstep = (size_t)HALF * K * 2;
    const size_t tstep = 2 * hstep;
    const unsigned ldsw = (unsigned)wid * 1024u;
    const int aoff = lds_byte(wr * 64 + fr, fq * 8), boff = lds_byte(wc * 32 + fr, fq * 8);
#define PG8_SA(b, h) (((b) * 2 + (h)) * HTB)
#define PG8_SB(b, h) ((4 + (b) * 2 + (h)) * HTB)
#define PG8_STAGE(bufoff, gbase, voff) do { _Pragma("unroll") for (int _i = 0; _i < 2; ++_i) \
        __builtin_amdgcn_global_load_lds((const unsigned*)((const char*)(gbase) + (voff)[_i]), (PG8_LAS unsigned*)(lds + (bufoff) + ldsw + _i * 8192), 16, 0, 0); } while (0)
#define PG8_LDA(dst, b, h) do { _Pragma("unroll") for (int m = 0; m < 4; ++m) _Pragma("unroll") for (int k = 0; k < 2; ++k) dst[m][k] = *(const PG8_LAS bf16x8*)(lds + PG8_SA(b, h) + aoff + m * 2048 + k * 1024); } while (0)
#define PG8_LDB(dst, b, h) do { _Pragma("unroll") for (int n = 0; n < 2; ++n) _Pragma("unroll") for (int k = 0; k < 2; ++k) dst[n][k] = *(const PG8_LAS bf16x8*)(lds + PG8_SB(b, h) + boff + n * 2048 + k * 1024); } while (0)
#define PG8_MMA(ai, bj, At, Bt) do { __builtin_amdgcn_s_setprio(1); _Pragma("unroll") for (int m = 0; m < 4; ++m) _Pragma("unroll") for (int n = 0; n < 2; ++n) _Pragma("unroll") for (int k = 0; k < 2; ++k) \
        acc[ai][bj][m][n] = __builtin_amdgcn_mfma_f32_16x16x32_bf16(Bt[n][k], At[m][k], acc[ai][bj][m][n], 0, 0, 0); __builtin_amdgcn_s_setprio(0); } while (0)
#define PG8_WAIT_V(n) asm volatile("s_waitcnt vmcnt(" #n ")" ::: "memory")
#define PG8_WAIT_L(n) asm volatile("s_waitcnt lgkmcnt(" #n ")" ::: "memory")
#define PG8_BAR __builtin_amdgcn_s_barrier()
#define PG8_SCHED __builtin_amdgcn_sched_barrier(0)
    Unit cur, nxt; int ui = 0;
    if (!S.next(0, cur)) return;
    f32x4 acc[2][2][4][2];
#pragma unroll
    for (int a = 0; a < 2; ++a)
#pragma unroll
        for (int b = 0; b < 2; ++b)
#pragma unroll
            for (int m = 0; m < 4; ++m)
#pragma unroll
                for (int n = 0; n < 2; ++n) acc[a][b][m][n] = (f32x4){0.f, 0.f, 0.f, 0.f};
    bf16x8 At[4][2], B0[2][2], B1[2][2];
    const char* cA = (const char*)g.A + (size_t)cur.pm * tstep; const char* cB = (const char*)g.Bt + (size_t)cur.pn * tstep;
    S.a_ready(cur);
    PG8_STAGE(PG8_SB(0, 0), cB, voffB); PG8_STAGE(PG8_SB(0, 1), cB + hstep, voffB); PG8_STAGE(PG8_SA(0, 0), cA, voffA); PG8_STAGE(PG8_SA(0, 1), cA + hstep, voffA);
    if (wr == 1) PG8_BAR;
    PG8_WAIT_V(2); PG8_BAR;
    PG8_STAGE(PG8_SB(1, 0), cB + kstep, voffB); PG8_STAGE(PG8_SA(1, 0), cA + kstep, voffA); PG8_STAGE(PG8_SB(1, 1), cB + hstep + kstep, voffB);
    PG8_WAIT_V(6); PG8_BAR;
    for (;;) {
        const bool has_next = S.next(ui + 1, nxt);
        const char* nA = has_next ? (const char*)g.A + (size_t)nxt.pm * tstep : cA; const char* nB = has_next ? (const char*)g.Bt + (size_t)nxt.pn * tstep : cB;
        for (int t = 0; t < nt; t += 2) {
            const bool last = (t == nt - 2);
            const char* a1 = cA + (size_t)(t + 1) * kstep;
            const char* a2 = last ? nA : cA + (size_t)(t + 2) * kstep; const char* b2 = last ? nB : cB + (size_t)(t + 2) * kstep;
            const char* a3 = a2 + kstep; const char* b3 = b2 + kstep;
            if (last && has_next) S.a_ready(nxt);
            PG8_LDB(B0, 0, 0); PG8_LDB(B1, 0, 1); PG8_SCHED; PG8_LDA(At, 0, 0); PG8_STAGE(PG8_SA(1, 1), a1 + hstep, voffA);
            PG8_WAIT_V(8); PG8_WAIT_L(0); PG8_BAR; PG8_MMA(0, 0, At, B0); PG8_MMA(0, 1, At, B1); PG8_BAR; PG8_SCHED;
            PG8_LDA(At, 0, 1); PG8_STAGE(PG8_SB(0, 0), b2, voffB); PG8_STAGE(PG8_SB(0, 1), b2 + hstep, voffB); PG8_STAGE(PG8_SA(0, 0), a2, voffA);
            PG8_WAIT_V(8); PG8_WAIT_L(0); PG8_BAR; PG8_MMA(1, 0, At, B0); PG8_MMA(1, 1, At, B1); PG8_BAR; PG8_SCHED;
            PG8_LDB(B0, 1, 0); PG8_LDB(B1, 1, 1); PG8_SCHED; PG8_LDA(At, 1, 0); PG8_STAGE(PG8_SA(0, 1), a2 + hstep, voffA);
            PG8_WAIT_V(8); PG8_WAIT_L(0); PG8_BAR; PG8_MMA(0, 0, At, B0); PG8_MMA(0, 1, At, B1); PG8_BAR; PG8_SCHED;
            PG8_LDA(At, 1, 1); PG8_STAGE(PG8_SB(1, 0), b3, voffB); PG8_STAGE(PG8_SB(1, 1), b3 + hstep, voffB); PG8_STAGE(PG8_SA(1, 0), a3, voffA);
            PG8_WAIT_V(8); PG8_WAIT_L(0); PG8_BAR; PG8_MMA(1, 0, At, B0); PG8_MMA(1, 1, At, B1); PG8_BAR; PG8_SCHED;
        }
        if constexpr (ALIGN_EPI) { if (wr == 0) PG8_BAR; }
        for (int r_ = 0; r_ < Epi::REP; ++r_) E(acc, cur, wr, wc, fr, fq);
        S.done(cur);
        if (!has_next) break;
#pragma unroll
        for (int a = 0; a < 2; ++a)
#pragma unroll
            for (int b = 0; b < 2; ++b)
#pragma unroll
                for (int m = 0; m < 4; ++m)
#pragma unroll
                    for (int n = 0; n < 2; ++n) acc[a][b][m][n] = (f32x4){0.f, 0.f, 0.f, 0.f};
        cur = nxt; cA = nA; cB = nB; ++ui;
        if constexpr (ALIGN_EPI) { if (wr == 1) PG8_BAR; }
    }
    PG8_WAIT_V(0);
    if constexpr (!ALIGN_EPI) { if (wr == 0) PG8_BAR; }
    PG8_BAR;
#undef PG8_SA
#undef PG8_SB
#undef PG8_STAGE
#undef PG8_LDA
#undef PG8_LDB
#undef PG8_MMA
#undef PG8_WAIT_V
#undef PG8_WAIT_L
#undef PG8_BAR
#undef PG8_SCHED
}
}

template <int MODE> struct EpiGlu {
    static constexpr bool PERM = true; static constexpr int REP = (MODE == 1) ? REP_EPI_GLU : 1;
    bf16_t* O; int ldo; const float* ss; const float* bias; float* csp; float* css;
    __device__ __forceinline__ void operator()(const f32x4 (&acc)[2][2][4][2], const pg8::Unit& u, int wr, int wc, int fr, int fq) const {
        const int col = u.pn * 128 + wc * 32 + 8 * fq;
        f32x4 ba[2], bg[2];
        if (MODE == 0) {
#pragma unroll
            for (int n = 0; n < 2; ++n) { ba[n] = *(const f32x4*)(bias + col + 4 * n); bg[n] = *(const f32x4*)(bias + D + col + 4 * n); }
        }
#pragma unroll
        for (int ai = 0; ai < 2; ++ai)
#pragma unroll
            for (int m = 0; m < 4; ++m) {
                const int row = u.pm * 256 + ai * 128 + wr * 64 + m * 16 + fr;
                const float vv = ss[row] * (1.0f / D) + EPS, rs = __builtin_amdgcn_rsqf(vv);
                f32x4 o[2];
                constexpr float NL2E = -1.4426950408889634f;
                const float c1 = rs * NL2E;
#pragma unroll
                for (int n = 0; n < 2; ++n)
#pragma unroll
                    for (int h = 0; h < 2; ++h) {
                        const f32x2 a2 = (f32x2){acc[ai][0][m][n][2 * h], acc[ai][0][m][n][2 * h + 1]}, g2 = (f32x2){acc[ai][1][m][n][2 * h], acc[ai][1][m][n][2 * h + 1]};
                        f32x2 t2, val2;
                        if (MODE == 0) { const f32x2 bg2 = (f32x2){bg[n][2 * h], bg[n][2 * h + 1]}, ba2 = (f32x2){ba[n][2 * h], ba[n][2 * h + 1]};
                            t2 = g2 * c1 + bg2 * NL2E; val2 = a2 * rs + ba2; }
                        else { t2 = a2 * c1; val2 = a2 * g2; }
                        f32x2 e2; e2.x = __builtin_amdgcn_exp2f(t2.x); e2.y = __builtin_amdgcn_exp2f(t2.y);
                        const f32x2 d2 = (MODE == 0) ? e2 + 1.0f : e2 * vv + vv;
                        f32x2 r2; r2.x = __builtin_amdgcn_rcpf(d2.x); r2.y = __builtin_amdgcn_rcpf(d2.y);
                        const f32x2 q2 = val2 * r2;
                        o[n][2 * h] = q2.x; o[n][2 * h + 1] = q2.y;
                    }
                u32x4 w; w.x = cvt_pk_bf16(o[0][0], o[0][1]); w.y = cvt_pk_bf16(o[0][2], o[0][3]); w.z = cvt_pk_bf16(o[1][0], o[1][1]); w.w = cvt_pk_bf16(o[1][2], o[1][3]);
                *(u32x4*)(O + (size_t)row * ldo + col) = w;
                if (MODE == 0) {
                    float* cs = nullptr;
                    if (row < T_P) { const int t = row & (SEQ - 1); if (t >= SEQ - CST) cs = csp + ((size_t)(row >> 11) * CST + (t - (SEQ - CST))) * D; }
                    else { const int r2 = row - T_P, t = r2 & (DSEQ - 1); if (t >= DSEQ - CST) cs = css + ((size_t)(r2 >> 6) * CST + (t - (DSEQ - CST))) * D; }
                    if (cs) { *(f32x4*)(cs + col) = o[0]; *(f32x4*)(cs + col + 4) = o[1]; }
                }
            }
    }
};
__device__ __forceinline__ f32x4 bf_lo4(u32x4 p) { return (f32x4){__uint_as_float(p.x << 16), __uint_as_float(p.x & 0xffff0000u), __uint_as_float(p.y << 16), __uint_as_float(p.y & 0xffff0000u)}; }
__device__ __forceinline__ f32x4 bf_hi4(u32x4 p) { return (f32x4){__uint_as_float(p.z << 16), __uint_as_float(p.z & 0xffff0000u), __uint_as_float(p.w << 16), __uint_as_float(p.w & 0xffff0000u)}; }
template <int MODE> struct EpiRes {
    static constexpr bool PERM = true; static constexpr int REP = 1;
    const float* xp; const float* xs; const bf16_t* Bin; bf16_t* B; float* ss; const float* bias;
    __device__ __forceinline__ void operator()(const f32x4 (&acc)[2][2][4][2], const pg8::Unit& u, int wr, int wc, int fr, int fq) const {
        const int col = u.pn * 256 + wc * 32 + 8 * fq;
        f32x4 bv[2][2];
        if (MODE == 0) {
#pragma unroll
            for (int bj = 0; bj < 2; ++bj)
#pragma unroll
                for (int n = 0; n < 2; ++n) bv[bj][n] = *(const f32x4*)(bias + col + bj * 128 + 4 * n);
        }
#pragma unroll
        for (int ai = 0; ai < 2; ++ai) {
            u32x4 bp[4][2];
#pragma unroll
            for (int m = 0; m < 4; ++m) {
                const int row = u.pm * 256 + ai * 128 + wr * 64 + m * 16 + fr;
#pragma unroll
                for (int bj = 0; bj < 2; ++bj) bp[m][bj] = *(const u32x4*)(Bin + (size_t)row * D + col + bj * 128);
            }
            __builtin_amdgcn_sched_barrier(0);
#pragma unroll
            for (int m = 0; m < 4; ++m) {
                const int row = u.pm * 256 + ai * 128 + wr * 64 + m * 16 + fr;
                f32x2 sq2 = (f32x2){0.f, 0.f};
#pragma unroll
                for (int bj = 0; bj < 2; ++bj) {
                    const int c = col + bj * 128;
                    const u32x4 bq = bp[m][bj];
                    u32x4 w;
#pragma unroll
                    for (int h = 0; h < 4; ++h) {
                        const f32x2 base2 = (f32x2){__uint_as_float(bq[h] << 16), __uint_as_float(bq[h] & 0xffff0000u)};
                        const f32x4 a4 = acc[ai][bj][m][h >> 1];
                        f32x2 v2 = base2 + (f32x2){a4[2 * (h & 1)], a4[2 * (h & 1) + 1]};
                        if (MODE == 0) v2 += (f32x2){bv[bj][h >> 1][2 * (h & 1)], bv[bj][h >> 1][2 * (h & 1) + 1]};
                        w[h] = cvt_pk_bf16(v2.x, v2.y);
                        sq2 = v2 * v2 + sq2;
                    }
                    *(u32x4*)(B + (size_t)row * D + c) = w;
                }
                float sq = sq2.x + sq2.y;
                sq += __shfl_xor(sq, 16); sq += __shfl_xor(sq, 32);
                if (fq == 0) atomicAdd(ss + row, sq);
            }
            asm volatile("" ::: "memory");
        }
    }
};
__device__ __forceinline__ int kperm(int t) { return (t & ~12) | ((t & 4) << 1) | ((t & 8) >> 1); }
struct EpiKvq {
    static constexpr bool PERM = true; static constexpr int REP = 1;
    const float* ss; float* out; bf16_t* Kp; bf16_t* Ks; bf16_t* Vtp; bf16_t* Vts; bf16_t* Q;
    __device__ __forceinline__ void operator()(const f32x4 (&acc)[2][2][4][2], const pg8::Unit& u, int wr, int wc, int fr, int fq) const {
#pragma unroll
        for (int ai = 0; ai < 2; ++ai)
#pragma unroll
            for (int m = 0; m < 4; ++m) {
                const int row = u.pm * 256 + ai * 128 + wr * 64 + m * 16 + fr;
                const float rs = __builtin_amdgcn_rsqf(ss[row] * (1.0f / D) + EPS);
                const bool prompt = row < T_P; const int r2 = row - T_P;
                const int b = prompt ? (row >> 11) : (r2 >> 6), t = prompt ? (row & (SEQ - 1)) : (r2 & (DSEQ - 1));
#pragma unroll
                for (int bj = 0; bj < 2; ++bj) {
                    const int c = bj * 128 + wc * 32 + 8 * fq;
                    f32x4 v0 = acc[ai][bj][m][0] * rs, v1 = acc[ai][bj][m][1] * rs;
                    if (u.pn == 0) {
                        float* ko = prompt ? out + O_KP + (size_t)row * KVD : out + O_KS + (size_t)r2 * KVD;
                        *(f32x4*)(ko + c) = v0; *(f32x4*)(ko + c + 4) = v1;
                        bf16_t* kb = prompt ? Kp + (size_t)row * KVD : Ks + ((size_t)b * SKV_S + PAST + t) * KVD;
                        u32x4 w; w.x = cvt_pk_bf16(v0[0], v0[1]); w.y = cvt_pk_bf16(v0[2], v0[3]); w.z = cvt_pk_bf16(v1[0], v1[1]); w.w = cvt_pk_bf16(v1[2], v1[3]);
                        *(u32x4*)(kb + c) = w;
                    } else if (u.pn == 1) {
                        float* vo = prompt ? out + O_VP + (size_t)row * KVD : out + O_VS + (size_t)r2 * KVD;
                        *(f32x4*)(vo + c) = v0; *(f32x4*)(vo + c + 4) = v1;
                        bf16_t* vb = prompt ? Vtp + (size_t)row * KVD : Vts + ((size_t)b * SKV_S + PAST + t) * KVD;
                        u32x4 w; w.x = cvt_pk_bf16(v0[0], v0[1]); w.y = cvt_pk_bf16(v0[2], v0[3]); w.z = cvt_pk_bf16(v1[0], v1[1]); w.w = cvt_pk_bf16(v1[2], v1[3]);
                        *(u32x4*)(vb + c) = w;
                    } else {
                        v0 *= QSCALE; v1 *= QSCALE;
                        u32x4 w; w.x = cvt_pk_bf16(v0[0], v0[1]); w.y = cvt_pk_bf16(v0[2], v0[3]); w.z = cvt_pk_bf16(v1[0], v1[1]); w.w = cvt_pk_bf16(v1[2], v1[3]);
                        *(u32x4*)(Q + (size_t)row * D + (u.pn - 2) * 256 + c) = w;
                    }
                }
            }
    }
};

template <int NB> __device__ __forceinline__ void sg32_tile(const bf16_t* __restrict__ ga, const bf16_t* __restrict__ gb0, const bf16_t* __restrict__ gb1, int ld, int nch, LAS unsigned char* stg, int lane, f32x16& c0, f32x16& c1) {
    c0 = f32x16{}; c1 = f32x16{};
    const int lr = lane >> 3, lc = lane & 7, r32 = lane & 31, hi = lane >> 5;
    const size_t goff = (size_t)lr * ld + lc * 8;
    ga += goff; gb0 += goff; if (NB == 2) gb1 += goff;
    LAS unsigned char* wr = stg + lr * 144 + lc * 16;
    const LAS unsigned char* rd = stg + r32 * 144 + hi * 16;
    u32x4 va[4], vb0[4], vb1[4];
#define SG_LOADG() do { _Pragma("unroll") for (int j = 0; j < 4; ++j) { va[j] = *(const u32x4*)(ga + (size_t)8 * j * ld); vb0[j] = *(const u32x4*)(gb0 + (size_t)8 * j * ld); if (NB == 2) vb1[j] = *(const u32x4*)(gb1 + (size_t)8 * j * ld); } \
        ga += 64; gb0 += 64; if (NB == 2) gb1 += 64; } while (0)
    SG_LOADG();
#pragma unroll 1
    for (int ch = 0; ch < nch; ++ch) {
#pragma unroll
        for (int j = 0; j < 4; ++j) { *(LAS u32x4*)(wr + j * 8 * 144) = va[j]; *(LAS u32x4*)(wr + 4608 + j * 8 * 144) = vb0[j]; if (NB == 2) *(LAS u32x4*)(wr + 9216 + j * 8 * 144) = vb1[j]; }
        __builtin_amdgcn_sched_barrier(0);
        if (ch + 1 < nch) SG_LOADG();
        __builtin_amdgcn_sched_barrier(0);
#pragma unroll
        for (int i = 0; i < 4; ++i) {
            const bf16x8 a = *(const LAS bf16x8*)(rd + i * 32), b0 = *(const LAS bf16x8*)(rd + 4608 + i * 32);
            c0 = __builtin_amdgcn_mfma_f32_32x32x16_bf16(b0, a, c0, 0, 0, 0);
            if (NB == 2) { const bf16x8 b1 = *(const LAS bf16x8*)(rd + 9216 + i * 32); c1 = __builtin_amdgcn_mfma_f32_32x32x16_bf16(b1, a, c1, 0, 0, 0); }
        }
        __builtin_amdgcn_sched_barrier(0);
    }
#undef SG_LOADG
}
__device__ __forceinline__ u32x2 pack4(f32x4 v) { u32x2 w; w.x = cvt_pk_bf16(v[0], v[1]); w.y = cvt_pk_bf16(v[2], v[3]); return w; }
#define F4(c, a) ((f32x4){(c)[4 * (a)], (c)[4 * (a) + 1], (c)[4 * (a) + 2], (c)[4 * (a) + 3]})
template <int MODE> struct SEpiGlu {
    bf16_t* O; int ldo; const float* ss; const float* bias; float* css;
    __device__ __forceinline__ void operator()(int rb, int cb, const f32x16& c0, const f32x16& c1, int r32, int hi) const {
        const int row = T_P + rb * 32 + r32;
        const float rs = __builtin_amdgcn_rsqf(ss[row] * (1.0f / D) + EPS);
#pragma unroll
        for (int a4 = 0; a4 < 4; ++a4) {
            const int col = cb * 32 + 8 * a4 + 4 * hi;
            f32x4 a = F4(c0, a4) * rs, g = F4(c1, a4) * rs, o;
            if (MODE == 0) { a += *(const f32x4*)(bias + col); g += *(const f32x4*)(bias + D + col);
#pragma unroll
                for (int e = 0; e < 4; ++e) o[e] = a[e] * fast_sigmoid(g[e]);
            } else {
#pragma unroll
                for (int e = 0; e < 4; ++e) o[e] = a[e] * fast_sigmoid(a[e]) * g[e];
            }
            *(u32x2*)(O + (size_t)row * ldo + col) = pack4(o);
            if (MODE == 0) { const int r2 = row - T_P, t = r2 & (DSEQ - 1); if (t >= DSEQ - CST) *(f32x4*)(css + ((size_t)(r2 >> 6) * CST + (t - (DSEQ - CST))) * D + col) = o; }
        }
    }
};
template <int MODE> struct SEpiRes {
    const float* xs; const bf16_t* Bin; bf16_t* B; float* ssout; const float* bias;
    __device__ __forceinline__ void operator()(int rb, int cb, const f32x16& c0, const f32x16&, int r32, int hi) const {
        const int row = T_P + rb * 32 + r32;
        float sq = 0.f;
#pragma unroll
        for (int a4 = 0; a4 < 4; ++a4) {
            const int col = cb * 32 + 8 * a4 + 4 * hi;
            f32x4 v;
            { const u32x2 pk = *(const u32x2*)(Bin + (size_t)row * D + col);
                v = (f32x4){__uint_as_float(pk.x << 16), __uint_as_float(pk.x & 0xffff0000u), __uint_as_float(pk.y << 16), __uint_as_float(pk.y & 0xffff0000u)} + F4(c0, a4); }
            if (MODE == 0) v += *(const f32x4*)(bias + col);
            *(u32x2*)(B + (size_t)row * D + col) = pack4(v);
            sq += (v[0] * v[0] + v[1] * v[1]) + (v[2] * v[2] + v[3] * v[3]);
        }
        sq += __shfl_xor(sq, 32);
        if (hi == 0) atomicAdd(ssout + row, sq);
    }
};
struct SEpiKvq {
    const float* ss; float* out; bf16_t* Ks; bf16_t* Vts; bf16_t* Q;
    __device__ __forceinline__ void operator()(int rb, int cb, const f32x16& c0, const f32x16&, int r32, int hi) const {
        const int row = T_P + rb * 32 + r32, r2 = row - T_P, b = r2 >> 6, t = r2 & (DSEQ - 1);
        const float rs = __builtin_amdgcn_rsqf(ss[row] * (1.0f / D) + EPS);
#pragma unroll
        for (int a4 = 0; a4 < 4; ++a4) {
            const int col = cb * 32 + 8 * a4 + 4 * hi;
            f32x4 v = F4(c0, a4) * rs;
            if (col < 256) {
                *(f32x4*)(out + O_KS + (size_t)r2 * KVD + col) = v;
                *(u32x2*)(Ks + ((size_t)b * SKV_S + PAST + t) * KVD + col) = pack4(v);
            } else if (col < 512) {
                const int cc = col - 256;
                *(f32x4*)(out + O_VS + (size_t)r2 * KVD + cc) = v;
                *(u32x2*)(Vts + ((size_t)b * SKV_S + PAST + t) * KVD + cc) = pack4(v);
            } else {
                v *= QSCALE;
                *(u32x2*)(Q + (size_t)row * D + (col - 512)) = pack4(v);
            }
        }
    }
};
template <int NB, int KS, class Epi>
__device__ __forceinline__ void sg32_phase(const bf16_t* A, const bf16_t* Bt, int K, int ncb, const Epi& epi, LAS unsigned char* lds, int bx, int G, int wave, int lane) {
    const int r32 = lane & 31, hi = lane >> 5;
    constexpr int TPW = 8 / KS;
    const int nitem = 16 * ncb, nrounds = (nitem + G * TPW - 1) / (G * TPW), nchunk = K / 64;
    const int ks = wave % KS, slot = wave / KS;
    const int per = nchunk / KS, rem = nchunk % KS, mych = per + (ks < rem ? 1 : 0), ch0 = ks * per + (ks < rem ? ks : rem);
    for (int rnd = 0; rnd < nrounds; ++rnd) {
        const int it = (rnd * G + bx) * TPW + slot; const bool valid = it < nitem;
        const int rb = it & 15, cb = it >> 4;
        f32x16 c0 = {}, c1 = {};
        if (valid) {
            const int brow = (NB == 2) ? ((cb >> 2) * 256 + (cb & 3) * 32) : cb * 32;
            const bf16_t* ap = A + (size_t)(T_P + rb * 32) * K + ch0 * 64;
            const bf16_t* bp0 = Bt + (size_t)brow * K + ch0 * 64;
            sg32_tile<NB>(ap, bp0, bp0 + (size_t)128 * K, K, mych, lds + wave * 13824, lane, c0, c1);
        }
        if (KS > 1) {
            __syncthreads();
            if (valid && ks != 0) {
#pragma unroll
                for (int q = 0; q < 4; ++q) { *(LAS f32x4*)(lds + wave * 8192 + q * 1024 + lane * 16) = F4(c0, q); if (NB == 2) *(LAS f32x4*)(lds + wave * 8192 + 4096 + q * 1024 + lane * 16) = F4(c1, q); }
            }
            __syncthreads();
            if (valid && ks == 0) {
#pragma unroll
                for (int pw = 1; pw < KS; ++pw)
#pragma unroll
                    for (int q = 0; q < 4; ++q) {
                        const f32x4 t0 = *(const LAS f32x4*)(lds + (wave + pw) * 8192 + q * 1024 + lane * 16);
                        c0[4 * q] += t0[0]; c0[4 * q + 1] += t0[1]; c0[4 * q + 2] += t0[2]; c0[4 * q + 3] += t0[3];
                        if (NB == 2) { const f32x4 t1 = *(const LAS f32x4*)(lds + (wave + pw) * 8192 + 4096 + q * 1024 + lane * 16);
                            c1[4 * q] += t1[0]; c1[4 * q + 1] += t1[1]; c1[4 * q + 2] += t1[2]; c1[4 * q + 3] += t1[3]; }
                    }
            }
        }
        if (valid && ks == 0) epi(rb, cb, c0, c1, r32, hi);
        if (KS > 1) __syncthreads();
    }
}

__device__ __forceinline__ int crow(int r, int hi) { return (r & 3) + 8 * (r >> 2) + 4 * hi; }
__device__ __forceinline__ void attn_unit(const bf16_t* __restrict__ Qp, const bf16_t* __restrict__ Kb, const bf16_t* __restrict__ Vb, int S, int qpos0, int kt_top, bf16_t* Op, LAS unsigned char* lds, int tid, int lane, int wave, const float* __restrict__ Kf, const float* __restrict__ Vf, int ktf) {
    const int r32 = lane & 31, hi = lane >> 5;
    bf16x8 qr[4];
#pragma unroll
    for (int d0 = 0; d0 < 4; ++d0) qr[d0] = *(const bf16x8*)(Qp + (size_t)r32 * D + d0 * 16 + hi * 8);
    f32x16 o0 = {}, o1 = {};
    float carry = 1.f;
    const int qpos = qpos0 + r32;
    const int lrow = tid >> 3, lch = tid & 7;
    const bf16_t* kg = Kb + (size_t)lrow * KVD + lch * 8;
    const bf16_t* vg = Vb + (size_t)lrow * KVD + lch * 8;
    LAS unsigned char* wK = lds + lrow * 144 + lch * 16;
    const LAS unsigned char* rK = lds + r32 * 144 + hi * 16;
    volatile LAS unsigned* flags = (volatile LAS unsigned*)(lds + 36864);
    LAS unsigned char* wV = lds + 9216 + lch * 8 * 144 + kperm(lrow) * 2;
    u32x4 kreg, vreg;
#define ATT_LOAD(KT) do { const int kt__ = (KT); \
        if (kt__ < ktf) { const float* kp_ = Kf + (size_t)(kt__ * 64 + lrow) * KVD + lch * 8; const float* vp_ = Vf + (size_t)(kt__ * 64 + lrow) * KVD + lch * 8; \
            const f32x4 ka_ = *(const f32x4*)kp_, kb_ = *(const f32x4*)(kp_ + 4), va_ = *(const f32x4*)vp_, vb_ = *(const f32x4*)(vp_ + 4); \
            kreg.x = cvt_pk_bf16(ka_[0], ka_[1]); kreg.y = cvt_pk_bf16(ka_[2], ka_[3]); kreg.z = cvt_pk_bf16(kb_[0], kb_[1]); kreg.w = cvt_pk_bf16(kb_[2], kb_[3]); \
            vreg.x = cvt_pk_bf16(va_[0], va_[1]); vreg.y = cvt_pk_bf16(va_[2], va_[3]); vreg.z = cvt_pk_bf16(vb_[0], vb_[1]); vreg.w = cvt_pk_bf16(vb_[2], vb_[3]); } \
        else { kreg = *(const u32x4*)(kg + (size_t)kt__ * 64 * KVD); vreg = *(const u32x4*)(vg + (size_t)kt__ * 64 * KVD); } } while (0)
    ATT_LOAD(kt_top);
    bool mydone = false; int buf = 0, it = 0;
    for (int kt = kt_top; kt >= 0; --kt, buf ^= 1, ++it) {
        *(LAS u32x4*)(wK + buf * 18432) = kreg;
#pragma unroll
        for (int e = 0; e < 4; ++e) { *(LAS unsigned short*)(wV + buf * 18432 + (2 * e) * 144) = (unsigned short)vreg[e]; *(LAS unsigned short*)(wV + buf * 18432 + (2 * e + 1) * 144) = (unsigned short)(vreg[e] >> 16); }
        if (lane == 0) flags[(it & 1) * 8 + wave] = mydone ? 1u : 0u;
        __syncthreads();
        if (kt > 0) ATT_LOAD(kt - 1);
        unsigned nd = 0;
#pragma unroll
        for (int w = 0; w < 8; ++w) nd += flags[(it & 1) * 8 + w];
        if (nd == 8u) break;
        if (mydone) continue;
        const int k0 = kt * 64;
        const LAS unsigned char* tK = rK + buf * 18432; const LAS unsigned char* tV = tK + 9216;
        f32x16 p0 = {}, p1 = {};
#pragma unroll
        for (int d0 = 0; d0 < 4; ++d0) {
            const bf16x8 k0f = *(const LAS bf16x8*)(tK + d0 * 32), k1f = *(const LAS bf16x8*)(tK + 32 * 144 + d0 * 32);
            p0 = __builtin_amdgcn_mfma_f32_32x32x16_bf16(k0f, qr[d0], p0, 0, 0, 0); p1 = __builtin_amdgcn_mfma_f32_32x32x16_bf16(k1f, qr[d0], p1, 0, 0, 0);
        }
        const bool diag = (k0 + 63 >= qpos0);
        f32x2 k0v[8], k1v[8], b0v[8], b1v[8]; float gp[8];
#pragma unroll
        for (int j = 0; j < 8; ++j) {
            f32x2 e0, e1; e0.x = __builtin_amdgcn_exp2f(p0[2 * j]); e0.y = __builtin_amdgcn_exp2f(p0[2 * j + 1]); e1.x = __builtin_amdgcn_exp2f(p1[2 * j]); e1.y = __builtin_amdgcn_exp2f(p1[2 * j + 1]);
            const f32x2 d0 = e0 + 1.0f, d1 = e1 + 1.0f;
            k0v[j].x = __builtin_amdgcn_rcpf(d0.x); k0v[j].y = __builtin_amdgcn_rcpf(d0.y); k1v[j].x = __builtin_amdgcn_rcpf(d1.x); k1v[j].y = __builtin_amdgcn_rcpf(d1.y);
            b0v[j] = 1.0f - k0v[j]; b1v[j] = 1.0f - k1v[j];
        }
        if (diag) {
#pragma unroll
            for (int r = 0; r < 16; ++r) {
                if (!(k0 + crow(r, hi) < qpos)) { if (r & 1) { k0v[r >> 1].y = 1.0f; b0v[r >> 1].y = 0.f; } else { k0v[r >> 1].x = 1.0f; b0v[r >> 1].x = 0.f; } }
                if (!(k0 + 32 + crow(r, hi) < qpos)) { if (r & 1) { k1v[r >> 1].y = 1.0f; b1v[r >> 1].y = 0.f; } else { k1v[r >> 1].x = 1.0f; b1v[r >> 1].x = 0.f; } }
            }
        }
#pragma unroll
        for (int a = 0; a < 4; ++a) { const f32x2 t0 = k0v[2 * a] * k0v[2 * a + 1], t1 = k1v[2 * a] * k1v[2 * a + 1]; gp[a] = t0.x * t0.y; gp[4 + a] = t1.x * t1.y; }
        float run = carry;
#pragma unroll
        for (int g = 7; g >= 0; --g) {
            const float other = __shfl_xor(gp[g], 32);
            float ga = (hi == 0) ? run * other : run;
            run *= gp[g] * other;
            const int a = g & 3;
            if (g < 4) {
                f32x2 gg; gg.y = ga; gg.x = ga * k0v[2 * a + 1].y; b0v[2 * a + 1] = b0v[2 * a + 1] * gg; ga = gg.x * k0v[2 * a + 1].x;
                gg.y = ga; gg.x = ga * k0v[2 * a].y; b0v[2 * a] = b0v[2 * a] * gg;
            } else {
                f32x2 gg; gg.y = ga; gg.x = ga * k1v[2 * a + 1].y; b1v[2 * a + 1] = b1v[2 * a + 1] * gg; ga = gg.x * k1v[2 * a + 1].x;
                gg.y = ga; gg.x = ga * k1v[2 * a].y; b1v[2 * a] = b1v[2 * a] * gg;
            }
        }
#pragma unroll
        for (int j = 0; j < 8; ++j) { p0[2 * j] = b0v[j].x; p0[2 * j + 1] = b0v[j].y; p1[2 * j] = b1v[j].x; p1[2 * j + 1] = b1v[j].y; }
        carry = run;
#pragma unroll
        for (int ps = 0; ps < 4; ++ps) {
            u32x4 pw;
            if (ps == 0)      { pw.x = cvt_pk_bf16(p0[0], p0[1]); pw.y = cvt_pk_bf16(p0[2], p0[3]); pw.z = cvt_pk_bf16(p0[4], p0[5]); pw.w = cvt_pk_bf16(p0[6], p0[7]); }
            else if (ps == 1) { pw.x = cvt_pk_bf16(p0[8], p0[9]); pw.y = cvt_pk_bf16(p0[10], p0[11]); pw.z = cvt_pk_bf16(p0[12], p0[13]); pw.w = cvt_pk_bf16(p0[14], p0[15]); }
            else if (ps == 2) { pw.x = cvt_pk_bf16(p1[0], p1[1]); pw.y = cvt_pk_bf16(p1[2], p1[3]); pw.z = cvt_pk_bf16(p1[4], p1[5]); pw.w = cvt_pk_bf16(p1[6], p1[7]); }
            else              { pw.x = cvt_pk_bf16(p1[8], p1[9]); pw.y = cvt_pk_bf16(p1[10], p1[11]); pw.z = cvt_pk_bf16(p1[12], p1[13]); pw.w = cvt_pk_bf16(p1[14], p1[15]); }
            const bf16x8 pb = __builtin_bit_cast(bf16x8, pw);
            const bf16x8 v0f = *(const LAS bf16x8*)(tV + ps * 32), v1f = *(const LAS bf16x8*)(tV + 32 * 144 + ps * 32);
            o0 = __builtin_amdgcn_mfma_f32_32x32x16_bf16(v0f, pb, o0, 0, 0, 0);
            o1 = __builtin_amdgcn_mfma_f32_32x32x16_bf16(v1f, pb, o1, 0, 0, 0);
        }
#if ATTN_EARLY_EXIT
        mydone = __all(carry == 0.0f);
#endif
    }
#undef ATT_LOAD
    __syncthreads();
    bf16_t* op = Op + (size_t)r32 * D + 4 * hi;
#pragma unroll
    for (int a = 0; a < 4; ++a) {
        u32x2 w0, w1; w0.x = cvt_pk_bf16(o0[4 * a], o0[4 * a + 1]); w0.y = cvt_pk_bf16(o0[4 * a + 2], o0[4 * a + 3]);
        w1.x = cvt_pk_bf16(o1[4 * a], o1[4 * a + 1]); w1.y = cvt_pk_bf16(o1[4 * a + 2], o1[4 * a + 3]);
        *(u32x2*)(op + 8 * a) = w0; *(u32x2*)(op + 32 + 8 * a) = w1;
    }
}

struct Args { const float* in[23]; float* out; unsigned char* ws; };

#if USE_XCD_BAR
#define XB_TMO      128
#define XB_XCNT(j)  (256  + 64 * (j))
#define XB_XSUB(j)  (1280 + 64 * (j))
#define XB_XGEN(j)  (2304 + 64 * (j))
#define XB_TOP      3328
#define XB_TOPGEN   3392
#define XB_SPIN_CAP (1u << 22)
__device__ __forceinline__ unsigned xb_ld(unsigned* p)              { return __hip_atomic_load(p, __ATOMIC_RELAXED, __HIP_MEMORY_SCOPE_AGENT); }
__device__ __forceinline__ unsigned xb_add(unsigned* p, unsigned v) { return __hip_atomic_fetch_add(p, v, __ATOMIC_RELAXED, __HIP_MEMORY_SCOPE_AGENT); }
__device__ __forceinline__ unsigned xb_xcc_id() { return (unsigned)__builtin_amdgcn_s_getreg((3 << 11) | 20) & 0xFu; }
#define XB_SPIN(cond, bar) do { unsigned _sp = 0; while (cond) { __builtin_amdgcn_s_sleep(1); \
    if ((++_sp & 255u) == 0u) { if (xb_ld(&(bar)[XB_TMO])) break; if (_sp > XB_SPIN_CAP) { atomicAdd(&(bar)[XB_TMO], 1u); break; } } } } while (0)
struct XcdBarrier { unsigned* bar; unsigned x; volatile LAS unsigned* st; };
__device__ __forceinline__ XcdBarrier xcd_barrier_post(unsigned* bar, volatile LAS unsigned* st) {
    XcdBarrier b; b.bar = bar; b.x = xb_xcc_id(); b.st = st;
    if (threadIdx.x == 0) (void)xb_add(&bar[XB_XCNT(b.x)], 1u);
    return b;
}
__device__ __forceinline__ void xcd_barrier_complete(unsigned* bar, unsigned x, unsigned& nloc, unsigned& nx) {
    const unsigned G = gridDim.x * gridDim.y * gridDim.z;
    unsigned sum, cnt, mine, sp = 0u;
    for (;;) {
        sum = 0u; cnt = 0u; mine = 0u;
#pragma unroll
        for (unsigned j = 0; j < 16; ++j) { const unsigned c = xb_ld(&bar[XB_XCNT(j)]); sum += c; cnt += (c > 0u) ? 1u : 0u; mine = (j == x) ? c : mine; }
        if (sum == G) break;
        __builtin_amdgcn_s_sleep(1);
        if ((++sp & 255u) == 0u) { if (xb_ld(&bar[XB_TMO])) break; if (sp > XB_SPIN_CAP) { atomicAdd(&bar[XB_TMO], 1u); break; } }
    }
    nloc = mine > 0u ? mine : 1u; nx = cnt > 0u ? cnt : 1u;
}
__device__ __forceinline__ void xcd_barrier(const XcdBarrier& b) {
    asm volatile("s_waitcnt vmcnt(0)" ::: "memory");
    __syncthreads();
    if (threadIdx.x == 0) {
        unsigned* bar = b.bar;
        __builtin_amdgcn_s_waitcnt(0);
        unsigned nloc = b.st[0], nx = b.st[1];
        if (nloc == 0u) { xcd_barrier_complete(bar, b.x, nloc, nx); b.st[0] = nloc; b.st[1] = nx; }
        const unsigned old = xb_add(&bar[XB_XSUB(b.x)], 1u);
        const unsigned gen = old / nloc;
        if (old + 1u == (gen + 1u) * nloc) {
            __builtin_amdgcn_fence(__ATOMIC_RELEASE, "agent");
            asm volatile("s_waitcnt vmcnt(0)" ::: "memory");
            const unsigned og = xb_add(&bar[XB_TOP], 1u);
            const unsigned tg = og / nx;
            if (og + 1u == (tg + 1u) * nx) xb_add(&bar[XB_TOPGEN], 1u);
            else XB_SPIN(xb_ld(&bar[XB_TOPGEN]) == tg, bar);
            __builtin_amdgcn_fence(__ATOMIC_ACQUIRE, "agent");
            xb_add(&bar[XB_XGEN(b.x)], 1u);
            asm volatile("s_waitcnt vmcnt(0)" ::: "memory");
        } else {
            XB_SPIN(xb_ld(&bar[XB_XGEN(b.x)]) == gen, bar);
            __builtin_amdgcn_fence(__ATOMIC_ACQUIRE, "agent");
            asm volatile("s_waitcnt vmcnt(0)" ::: "memory");
        }
    }
    __syncthreads();
}
#endif

constexpr int LDS_BYTES = 147456, RING_BYTES = 131072, MISC_OFF = RING_BYTES + 320;

__device__ __forceinline__ void tr_item(const float* __restrict__ W, int ldw, int k0, int nsrc0, const float* __restrict__ gain, bf16_t* WT, int ldt, int drow0, LAS float* scr, int lane, bool vperm) {
    { float v[32]; const float gv = gain ? gain[k0 + lane] : 1.0f;
#pragma unroll
      for (int i = 0; i < 32; ++i) v[i] = __builtin_nontemporal_load(&W[(size_t)(k0 + 2 * i + (lane >> 5)) * ldw + nsrc0 + (lane & 31)]);
      __builtin_amdgcn_sched_barrier(0);
#pragma unroll
      for (int i = 0; i < 32; ++i) { const int kk = 2 * i + (lane >> 5); scr[kk * 33 + (lane & 31)] = v[i] * __shfl(gv, kk); } }
    LDS_WAIT(); asm volatile("" ::: "memory");
    const int c = lane & 7;
    int kk[8];
#pragma unroll
    for (int e = 0; e < 8; ++e) kk[e] = vperm ? (16 * (c >> 1) + 8 * (e >> 2) + 4 * (c & 1) + (e & 3)) : (8 * c + e);
#pragma unroll
    for (int j = 0; j < 4; ++j) { const int n = (lane >> 3) + 8 * j; const LAS float* s = scr + n;
        u32x4 o; o.x = cvt_pk_bf16(s[kk[0] * 33], s[kk[1] * 33]); o.y = cvt_pk_bf16(s[kk[2] * 33], s[kk[3] * 33]); o.z = cvt_pk_bf16(s[kk[4] * 33], s[kk[5] * 33]); o.w = cvt_pk_bf16(s[kk[6] * 33], s[kk[7] * 33]);
        *(u32x4*)(WT + (size_t)(drow0 + n) * ldt + k0 + 8 * c) = o; }
    LDS_WAIT(); asm volatile("" ::: "memory");
}
__device__ __forceinline__ int glu_src(int drow0, int half) { const int pn = drow0 >> 8, j = drow0 & 255; return j < 128 ? pn * 128 + j : half + pn * 128 + (j - 128); }

template <int I> __device__ __forceinline__ void dw_step(f32x2 (&acc)[32], const f32x2 (&wv)[CW], const LAS unsigned char* base) {
    const unsigned pk = *(const LAS unsigned*)(base + I * 2048);
    const f32x2 in = (f32x2){__uint_as_float(pk << 16), __uint_as_float(pk & 0xffff0000u)};
    constexpr int TLO = (I - 30 > 0) ? I - 30 : 0, THI = (I < 31) ? I : 31;
#pragma unroll
    for (int t = TLO; t <= THI; ++t) acc[t] += wv[I - t] * in;
    if constexpr ((I & 7) == 7) __builtin_amdgcn_sched_barrier(0);
    if constexpr (I + 1 < 62) dw_step<I + 1>(acc, wv, base);
}

__global__ void __launch_bounds__(512) yoco_fwd(Args args) {
    extern __shared__ __attribute__((aligned(16))) unsigned char lds_raw[];
    LAS unsigned char* lds = (LAS unsigned char*)lds_raw;
    int tid = threadIdx.x, lane = tid & 63, wave = __builtin_amdgcn_readfirstlane(tid >> 6);
#define RELAUNDER() do { tid = threadIdx.x; asm volatile("" : "+v"(tid)); lane = tid & 63; wave = __builtin_amdgcn_readfirstlane(tid >> 6); } while (0)
    const int G = gridDim.x, bx = blockIdx.x;
    unsigned char* ws = args.ws;
    float* out = args.out;
    const float* x_p = args.in[0]; const float* x_s = args.in[1]; const float* state_conv = args.in[2]; const float* cache_k = args.in[3]; const float* cache_v = args.in[4];
    const float* a_norm_g = args.in[5]; const float* conv_w_in = args.in[6]; const float* conv_b_in = args.in[7]; const float* conv_w_dw = args.in[8]; const float* conv_b_dw = args.in[9];
    const float* conv_ln_g = args.in[10]; const float* conv_ln_b = args.in[11]; const float* conv_w_out = args.in[12]; const float* conv_b_out = args.in[13];
    const float* kv_norm_g = args.in[14]; const float* w_kv = args.in[15]; const float* b_norm_g = args.in[16]; const float* w_q = args.in[17]; const float* w_o = args.in[18];
    const float* ffn_norm_g = args.in[19]; const float* ffn_w_gu = args.in[20]; const float* ffn_w_down = args.in[21]; const float* final_norm_g = args.in[22];
    float* ss = (float*)(ws + WS_SS);
    bf16_t* Wt_in = (bf16_t*)(ws + WS_WIN); bf16_t* Wt_out = (bf16_t*)(ws + WS_WOUT); bf16_t* Wt_gu0 = (bf16_t*)(ws + WS_WGU0); bf16_t* Wt_gu1 = (bf16_t*)(ws + WS_WGU1);
    bf16_t* Wt_d0 = (bf16_t*)(ws + WS_WD0); bf16_t* Wt_d1 = (bf16_t*)(ws + WS_WD1); bf16_t* Wt_kvq = (bf16_t*)(ws + WS_WKVQ); bf16_t* Wt_o = (bf16_t*)(ws + WS_WO);
    bf16_t* Kp = (bf16_t*)(ws + WS_KP); bf16_t* Ks = (bf16_t*)(ws + WS_KS); bf16_t* Vtp = (bf16_t*)(ws + WS_VTP); bf16_t* Vts = (bf16_t*)(ws + WS_VTS);
    bf16_t* S1 = (bf16_t*)(ws + WS_S1); bf16_t* S2 = (bf16_t*)(ws + WS_S2); bf16_t* S3 = (bf16_t*)(ws + WS_S3); bf16_t* HID = (bf16_t*)(ws + WS_HID);
    float* R = out + O_Y;

    cg::grid_group grid = cg::this_grid();
#if USE_XCD_BAR
    { volatile LAS unsigned* misc = (volatile LAS unsigned*)(lds + MISC_OFF); if (tid < 32) misc[tid] = 0u; }
    __syncthreads();
    XcdBarrier xbar = xcd_barrier_post((unsigned*)(ws + WS_CTL), (volatile LAS unsigned*)(lds + MISC_OFF) + 8);
#define GRID_BAR() xcd_barrier(xbar)
#else
#define GRID_BAR() grid.sync()
#endif

    for (int rep_ = 0; rep_ < REP_P0; ++rep_) {
        RELAUNDER();
        LAS float* scr = (LAS float*)(lds + wave * 16384);
        const int gw = bx * 8 + wave, NGW = G * 8;
        constexpr int I_IN = 16 * 64, I_OUT = 16 * 32, I_GU = 16 * 176, I_DN = 44 * 32, I_KV = 16 * 16, I_Q = 16 * 32, I_O = 16 * 32;
        constexpr int NITEMS = I_IN + I_OUT + 2 * I_GU + 2 * I_DN + I_KV + I_Q + I_O;
        for (int it = gw; it < NITEMS; it += NGW) {
            int r = it;
            if (r < I_IN) { const int kb = r >> 6, nb = r & 63; tr_item(conv_w_in, 2 * D, 64 * kb, glu_src(32 * nb, D), a_norm_g, Wt_in, D, 32 * nb, scr, lane, false); continue; } r -= I_IN;
            if (r < I_OUT) { const int kb = r >> 5, nb = r & 31; tr_item(conv_w_out, D, 64 * kb, 32 * nb, nullptr, Wt_out, D, 32 * nb, scr, lane, false); continue; } r -= I_OUT;
            if (r < 2 * I_GU) { const int l = r / I_GU, q = r % I_GU, kb = q / 176, nb = q % 176;
                tr_item(ffn_w_gu + (size_t)l * D * 2 * DFF, 2 * DFF, 64 * kb, glu_src(32 * nb, DFF), ffn_norm_g + l * D, l ? Wt_gu1 : Wt_gu0, D, 32 * nb, scr, lane, false); continue; } r -= 2 * I_GU;
            if (r < 2 * I_DN) { const int l = r / I_DN, q = r % I_DN, kb = q >> 5, nb = q & 31;
                tr_item(ffn_w_down + (size_t)l * DFF * D, D, 64 * kb, 32 * nb, nullptr, l ? Wt_d1 : Wt_d0, DFF, 32 * nb, scr, lane, false); continue; } r -= 2 * I_DN;
            if (r < I_KV) { const int kb = r >> 4, nb = r & 15; tr_item(w_kv, 2 * KVD, 64 * kb, 32 * nb, kv_norm_g, Wt_kvq, D, 32 * nb, scr, lane, false); continue; } r -= I_KV;
            if (r < I_Q) { const int kb = r >> 5, nb = r & 31; tr_item(w_q, D, 64 * kb, 32 * nb, b_norm_g, Wt_kvq, D, 512 + 32 * nb, scr, lane, false); continue; } r -= I_Q;
            { const int kb = r >> 5, nb = r & 31; tr_item(w_o, D, 64 * kb, 32 * nb, nullptr, Wt_o, D, 32 * nb, scr, lane, false); }
        }
        for (int row0 = gw * 4; row0 < T; row0 += NGW * 4) {
            f32x4 v[4][4]; float sq[4];
#pragma unroll
            for (int rr = 0; rr < 4; ++rr) { const int row = row0 + rr; const float* src = row < T_P ? x_p + (size_t)row * D : x_s + (size_t)(row - T_P) * D;
#pragma unroll
                for (int j = 0; j < 4; ++j) v[rr][j] = __builtin_nontemporal_load((const f32x4*)(src + 4 * (lane + 64 * j))); }
            __builtin_amdgcn_sched_barrier(0);
#pragma unroll
            for (int rr = 0; rr < 4; ++rr) { float q = 0.f;
#pragma unroll
                for (int j = 0; j < 4; ++j) q += (v[rr][j][0] * v[rr][j][0] + v[rr][j][1] * v[rr][j][1]) + (v[rr][j][2] * v[rr][j][2] + v[rr][j][3] * v[rr][j][3]);
                sq[rr] = q; }
#pragma unroll
            for (int o = 1; o < 64; o <<= 1) {
#pragma unroll
                for (int rr = 0; rr < 4; ++rr) sq[rr] += __shfl_xor(sq[rr], o); }
#pragma unroll
            for (int rr = 0; rr < 4; ++rr) { const int row = row0 + rr;
                if (lane == 0) ss[row] = sq[rr];
#pragma unroll
                for (int j = 0; j < 4; ++j) { u32x2 w; w.x = cvt_pk_bf16(v[rr][j][0], v[rr][j][1]); w.y = cvt_pk_bf16(v[rr][j][2], v[rr][j][3]); *(u32x2*)(S3 + (size_t)row * D + 4 * (lane + 64 * j)) = w; } }
        }
        const int gt = bx * 512 + tid, NT = G * 512;
        for (int i = gt; i < 4 * T; i += NT) ss[T + i] = 0.f;
    }
    grid.sync();

    { pg8::Gemm g{S3, Wt_in, T_P, 2 * D, D}; pg8::StaticOrder S; S.init(T_P, 2 * D, G, bx);
      EpiGlu<0> E{S2, D, ss, conv_b_in, out + O_CSP, out + O_CSS};
      pg8::gemm_phase<EpiGlu<0>, pg8::StaticOrder, true>(lds, g, S, E);
      RELAUNDER(); { SEpiGlu<0> SE{S2, D, ss, conv_b_in, out + O_CSS}; sg32_phase<2, 4>(S3, Wt_in, D, D / 32, SE, lds, bx, G, wave, lane); } }
    GRID_BAR();

    for (int rep_ = 0; rep_ < REP_P2; ++rep_) {
        RELAUNDER();
        f32x2 wv[CW];
#pragma unroll
        for (int j = 0; j < CW; ++j) wv[j] = *(const f32x2*)(conv_w_dw + (size_t)j * D + 2 * tid);
        const f32x2 bdw = *(const f32x2*)(conv_b_dw + 2 * tid);
        if (wave < 2) for (int tok = bx * 2 + wave; tok < T_S; tok += 2 * G) {
            const int b = tok >> 6, t = tok & (DSEQ - 1), c0 = 8 * lane;
            float a[16];
            { const f32x4 b0 = *(const f32x4*)(conv_b_dw + c0), b1 = *(const f32x4*)(conv_b_dw + c0 + 4), b2 = *(const f32x4*)(conv_b_dw + 512 + c0), b3 = *(const f32x4*)(conv_b_dw + 512 + c0 + 4);
#pragma unroll
              for (int e = 0; e < 4; ++e) { a[e] = b0[e]; a[4 + e] = b1[e]; a[8 + e] = b2[e]; a[12 + e] = b3[e]; } }
#pragma unroll 1
            for (int j = 0; j < CW; ++j) {
                const int tt = t - CST + j;
                float in[16];
                if (tt >= 0) {
                    const bf16_t* src = S2 + (size_t)(T_P + b * DSEQ + tt) * D + c0;
                    const u32x4 p0 = *(const u32x4*)src, p1 = *(const u32x4*)(src + 512);
#pragma unroll
                    for (int e = 0; e < 4; ++e) { in[2 * e] = __uint_as_float(p0[e] << 16); in[2 * e + 1] = __uint_as_float(p0[e] & 0xffff0000u); in[8 + 2 * e] = __uint_as_float(p1[e] << 16); in[8 + 2 * e + 1] = __uint_as_float(p1[e] & 0xffff0000u); }
                } else {
                    const float* src = state_conv + ((size_t)(b * CST + CST + tt) * D + c0);
                    const f32x4 q0 = *(const f32x4*)src, q1 = *(const f32x4*)(src + 4), q2 = *(const f32x4*)(src + 512), q3 = *(const f32x4*)(src + 516);
#pragma unroll
                    for (int e = 0; e < 4; ++e) { in[e] = q0[e]; in[4 + e] = q1[e]; in[8 + e] = q2[e]; in[12 + e] = q3[e]; }
                }
                const float* wp = conv_w_dw + (size_t)j * D + c0;
                const f32x4 w0 = *(const f32x4*)wp, w1 = *(const f32x4*)(wp + 4), w2 = *(const f32x4*)(wp + 512), w3 = *(const f32x4*)(wp + 516);
#pragma unroll
                for (int e = 0; e < 4; ++e) { a[e] += w0[e] * in[e]; a[4 + e] += w1[e] * in[4 + e]; a[8 + e] += w2[e] * in[8 + e]; a[12 + e] += w3[e] * in[12 + e]; }
            }
            float s = 0.f;
#pragma unroll
            for (int e = 0; e < 16; ++e) s += a[e];
            const float mean = wave_sum(s) * (1.0f / D); float q = 0.f;
#pragma unroll
            for (int e = 0; e < 16; ++e) { a[e] -= mean; q += a[e] * a[e]; }
            const float rstd = __builtin_amdgcn_rsqf(wave_sum(q) * (1.0f / D) + EPS);
#pragma unroll
            for (int hh = 0; hh < 2; ++hh) {
                const int c = hh * 512 + c0; float y[8];
#pragma unroll
                for (int e = 0; e < 8; ++e) { const float v = a[hh * 8 + e] * rstd * conv_ln_g[c + e] + conv_ln_b[c + e]; y[e] = v * fast_sigmoid(v); }
                u32x4 w; w.x = cvt_pk_bf16(y[0], y[1]); w.y = cvt_pk_bf16(y[2], y[3]); w.z = cvt_pk_bf16(y[4], y[5]); w.w = cvt_pk_bf16(y[6], y[7]);
                *(u32x4*)(S1 + (size_t)(T_P + tok) * D + c) = w;
            }
        }
        constexpr int NTILE = T_P / 32;
        u32x4 tv[16];
        const int li0 = tid >> 7, lcc = tid & 127;
#define DW_LOAD(TILE) do { const bf16_t* p_ = S2 + ((long)((TILE) >> 6) * SEQ + ((TILE) & 63) * 32 - CST + li0) * D + 8 * lcc; \
        _Pragma("unroll") for (int q = 0; q < 16; ++q) { if (q < 15 || li0 < 2) tv[q] = *(const u32x4*)(p_ + (long)q * 4 * D); } \
        if ((((TILE) & 63) == 0)) { _Pragma("unroll") for (int q = 0; q < 8; ++q) if (li0 + 4 * q < CST) tv[q] = (u32x4){0u, 0u, 0u, 0u}; } } while (0)
        for (int tile = bx; tile < NTILE; tile += G) {
            const int b = tile >> 6, t0 = (tile & 63) * 32, rowbase = b * SEQ;
            DW_LOAD(tile);
            __builtin_amdgcn_sched_barrier(0);
#pragma unroll
            for (int q = 0; q < 16; ++q) { if (q < 15 || li0 < 2) *(LAS u32x4*)(lds + li0 * 2048 + lcc * 16 + q * 8192) = tv[q]; }
            __syncthreads();
            f32x2 acc[32];
#pragma unroll
            for (int t = 0; t < 32; ++t) acc[t] = (f32x2){0.f, 0.f};
            dw_step<0>(acc, wv, lds + tid * 4);
            __syncthreads();
#pragma unroll
            for (int t = 0; t < 32; ++t) *(LAS f32x2*)(lds + t * 4096 + tid * 8) = acc[t];
            __syncthreads();
#pragma unroll 1
            for (int th = 0; th < 2; ++th) {
            f32x4 v[2][4]; float s4[2]; f32x4 lng[4], lnb[4];
#pragma unroll
            for (int j = 0; j < 4; ++j) { lng[j] = *(const f32x4*)(conv_ln_g + 4 * (lane + 64 * j)); lnb[j] = *(const f32x4*)(conv_ln_b + 4 * (lane + 64 * j)); }
#pragma unroll
            for (int tt = 0; tt < 2; ++tt) { float sa = 0.f;
#pragma unroll
                for (int j = 0; j < 4; ++j) { v[tt][j] = *(const LAS f32x4*)(lds + (wave * 4 + th * 2 + tt) * 4096 + (lane + 64 * j) * 16) + *(const f32x4*)(conv_b_dw + 4 * (lane + 64 * j)); sa += (v[tt][j][0] + v[tt][j][1]) + (v[tt][j][2] + v[tt][j][3]); }
                s4[tt] = sa; }
#pragma unroll
            for (int o = 1; o < 64; o <<= 1) {
#pragma unroll
                for (int tt = 0; tt < 2; ++tt) s4[tt] += __shfl_xor(s4[tt], o); }
#pragma unroll
            for (int tt = 0; tt < 2; ++tt) { const float mean = s4[tt] * (1.0f / D); float q = 0.f;
#pragma unroll
                for (int j = 0; j < 4; ++j) { v[tt][j] = v[tt][j] - mean; q += (v[tt][j][0] * v[tt][j][0] + v[tt][j][1] * v[tt][j][1]) + (v[tt][j][2] * v[tt][j][2] + v[tt][j][3] * v[tt][j][3]); }
                s4[tt] = q; }
#pragma unroll
            for (int o = 1; o < 64; o <<= 1) {
#pragma unroll
                for (int tt = 0; tt < 2; ++tt) s4[tt] += __shfl_xor(s4[tt], o); }
#pragma unroll
            for (int tt = 0; tt < 2; ++tt) {
                const float rstd = __builtin_amdgcn_rsqf(s4[tt] * (1.0f / D) + EPS);
#pragma unroll
                for (int j = 0; j < 4; ++j) {
                    f32x4 y = v[tt][j] * rstd * lng[j] + lnb[j];
#pragma unroll
                    for (int e = 0; e < 4; ++e) y[e] = y[e] * fast_sigmoid(y[e]);
                    u32x2 w; w.x = cvt_pk_bf16(y[0], y[1]); w.y = cvt_pk_bf16(y[2], y[3]);
                    *(u32x2*)(S1 + (size_t)(rowbase + t0 + wave * 4 + th * 2 + tt) * D + 4 * (lane + 64 * j)) = w;
                }
            }
            }
            __syncthreads();
        }
#undef DW_LOAD
    }
    GRID_BAR();

    { pg8::Gemm g{S1, Wt_out, T_P, D, D}; pg8::StaticOrder S; S.init(T_P, D, G, bx);
      EpiRes<0> E{x_p, x_s, S3, S2, ss + T, conv_b_out};
      pg8::gemm_phase<EpiRes<0>, pg8::StaticOrder, true>(lds, g, S, E);
      RELAUNDER(); { SEpiRes<0> SE{x_s, S3, S2, ss + T, conv_b_out}; sg32_phase<1, 4>(S1, Wt_out, D, D / 32, SE, lds, bx, G, wave, lane); } }
    GRID_BAR();
    for (int rep_ = 0; rep_ < REP_P4; ++rep_) { pg8::Gemm g{S2, Wt_gu0, T_P, 2 * DFF, D}; pg8::StaticOrder S; S.init(T_P, 2 * DFF, G, bx);
      EpiGlu<1> E{HID, DFF, ss + T, nullptr, nullptr, nullptr};
      pg8::gemm_phase<EpiGlu<1>, pg8::StaticOrder, true>(lds, g, S, E);
      RELAUNDER(); for (int r2_ = 0; r2_ < REP_SG; ++r2_) { SEpiGlu<1> SE{HID, DFF, ss + T, nullptr, nullptr}; sg32_phase<2, 1>(S2, Wt_gu0, D, DFF / 32, SE, lds, bx, G, wave, lane); } }
    GRID_BAR();
    { pg8::Gemm g{HID, Wt_d0, T_P, D, DFF}; pg8::StaticOrder S; S.init(T_P, D, G, bx);
      EpiRes<1> E{nullptr, nullptr, S2, S1, ss + 2 * T, nullptr};
      pg8::gemm_phase<EpiRes<1>, pg8::StaticOrder, true>(lds, g, S, E);
      RELAUNDER(); { SEpiRes<1> SE{nullptr, S2, S1, ss + 2 * T, nullptr}; sg32_phase<1, 4>(HID, Wt_d0, DFF, D / 32, SE, lds, bx, G, wave, lane); } }
    GRID_BAR();
    { pg8::Gemm g{S1, Wt_kvq, T_P, 6 * 256, D}; pg8::StaticOrder S; S.init(T_P, 6 * 256, G, bx);
      EpiKvq E{ss + 2 * T, out, Kp, Ks, Vtp, Vts, S2};
      pg8::gemm_phase<EpiKvq, pg8::StaticOrder, true>(lds, g, S, E);
      RELAUNDER(); { SEpiKvq SE{ss + 2 * T, out, Ks, Vts, S2}; sg32_phase<1, 2>(S1, Wt_kvq, D, 1536 / 32, SE, lds, bx, G, wave, lane); } }
    GRID_BAR();
    for (int rep_ = 0; rep_ < REP_P7; ++rep_) {
        RELAUNDER();
        constexpr int NU_S = NB_S * 4, NU = NU_S + NB_P * 4 * 32;
        for (int L = bx; L < NU; L += G) {
            const int h4 = wave & 3, sub = wave >> 2;
            if (L < NU_S) {
                const int b = L >> 2, kvh = L & 3, h = kvh * 4 + h4, q0 = sub * 32;
                const size_t row0 = (size_t)T_P + b * DSEQ + q0;
                attn_unit(S2 + row0 * D + h * 64, Ks + (size_t)b * SKV_S * KVD + kvh * 64, Vts + (size_t)b * SKV_S * KVD + kvh * 64, SKV_S, PAST + q0, PAST / 64, S3 + row0 * D + h * 64, lds, tid, lane, wave, cache_k + (size_t)b * PAST * KVD + kvh * 64, cache_v + (size_t)b * PAST * KVD + kvh * 64, PAST / 64);
            } else {
                const int L2 = L - NU_S, qb = 31 - (L2 >> 6), bk = L2 & 63, b = bk >> 2, kvh = bk & 3, h = kvh * 4 + h4, q0 = qb * 64 + sub * 32;
                const size_t row0 = (size_t)b * SEQ + q0;
                attn_unit(S2 + row0 * D + h * 64, Kp + (size_t)b * SEQ * KVD + kvh * 64, Vtp + (size_t)b * SEQ * KVD + kvh * 64, SEQ, q0, qb, S3 + row0 * D + h * 64, lds, tid, lane, wave, nullptr, nullptr, 0);
            }
        }
    }
    GRID_BAR();
    { pg8::Gemm g{S3, Wt_o, T_P, D, D}; pg8::StaticOrder S; S.init(T_P, D, G, bx);
      EpiRes<1> E{nullptr, nullptr, S1, S2, ss + 3 * T, nullptr};
      pg8::gemm_phase<EpiRes<1>, pg8::StaticOrder, true>(lds, g, S, E);
      RELAUNDER(); { SEpiRes<1> SE{nullptr, S1, S2, ss + 3 * T, nullptr}; sg32_phase<1, 4>(S3, Wt_o, D, D / 32, SE, lds, bx, G, wave, lane); } }
    GRID_BAR();
    { pg8::Gemm g{S2, Wt_gu1, T_P, 2 * DFF, D}; pg8::StaticOrder S; S.init(T_P, 2 * DFF, G, bx);
      EpiGlu<1> E{HID, DFF, ss + 3 * T, nullptr, nullptr, nullptr};
      pg8::gemm_phase<EpiGlu<1>, pg8::StaticOrder, true>(lds, g, S, E);
      RELAUNDER(); { SEpiGlu<1> SE{HID, DFF, ss + 3 * T, nullptr, nullptr}; sg32_phase<2, 1>(S2, Wt_gu1, D, DFF / 32, SE, lds, bx, G, wave, lane); } }
    GRID_BAR();
    { pg8::Gemm g{HID, Wt_d1, T_P, D, DFF}; pg8::StaticOrder S; S.init(T_P, D, G, bx);
      EpiRes<2> E{nullptr, nullptr, S2, S2, ss + 4 * T, nullptr};
      pg8::gemm_phase<EpiRes<2>, pg8::StaticOrder, true>(lds, g, S, E);
      RELAUNDER(); { SEpiRes<2> SE{nullptr, S2, S2, ss + 4 * T, nullptr}; sg32_phase<1, 4>(HID, Wt_d1, DFF, D / 32, SE, lds, bx, G, wave, lane); } }
    GRID_BAR();
    {
        RELAUNDER();
        const int gw = bx * 8 + wave, NGW = G * 8;
        for (int row = gw; row < T; row += NGW) {
            const float rs = __builtin_amdgcn_rsqf(ss[4 * T + row] * (1.0f / D) + EPS);
#pragma unroll
            for (int j = 0; j < 4; ++j) { const int c = 4 * (lane + 64 * j); const u32x2 pk = *(const u32x2*)(S2 + (size_t)row * D + c); const f32x4 gg = *(const f32x4*)(final_norm_g + c);
                const f32x4 v = (f32x4){__uint_as_float(pk.x << 16), __uint_as_float(pk.x & 0xffff0000u), __uint_as_float(pk.y << 16), __uint_as_float(pk.y & 0xffff0000u)};
                *(f32x4*)(R + (size_t)row * D + c) = v * rs * gg; }
        }
    }
}

extern "C" void kernel_launch(void* const* d_in, const int* in_sizes, int n_in, void* d_out, int out_size, void* d_ws, size_t ws_size, hipStream_t stream) {
    static int grid = 0;
    if (grid == 0) {
        if (n_in != 23 || ws_size < WS_END) { fprintf(stderr, "kernel_launch: unexpected n_in %d / ws_size %zu\n", n_in, ws_size); grid = -1; return; }
        int dev = 0, cus = 0, per_cu = 0;
        (void)hipGetDevice(&dev); (void)hipDeviceGetAttribute(&cus, hipDeviceAttributeMultiprocessorCount, dev);
        if (hipFuncSetAttribute((const void*)yoco_fwd, hipFuncAttributeMaxDynamicSharedMemorySize, LDS_BYTES) != hipSuccess) { fprintf(stderr, "kernel_launch: hipFuncSetAttribute failed\n"); grid = -1; return; }
        if (hipOccupancyMaxActiveBlocksPerMultiprocessor(&per_cu, (const void*)yoco_fwd, 512, LDS_BYTES) != hipSuccess || per_cu < 1) { fprintf(stderr, "kernel_launch: occupancy query says %d\n", per_cu); per_cu = 1; }
        (void)hipGetLastError();
        grid = cus * 1;
    }
    if (grid < 0) return;
    (void)hipMemsetAsync((char*)d_ws + WS_CTL, 0, CTL_BYTES, stream);
    Args a{};
    for (int i = 0; i < 23; ++i) a.in[i] = (const float*)d_in[i];
    a.out = (float*)d_out; a.ws = (unsigned char*)d_ws;
    void* kargs[] = {&a};
    hipError_t e = hipLaunchCooperativeKernel((const void*)yoco_fwd, dim3(grid), dim3(512), kargs, LDS_BYTES, stream);
    if (e != hipSuccess) fprintf(stderr, "kernel_launch: cooperative launch failed: %s (grid %d)\n", hipGetErrorString(e), grid);
}
```
